# Optimizing an MI355X kernel written in HIP

```python
import jax, jax.numpy as jnp
from jax import lax
import numpy as np

D_MODEL = 1024
BATCH = 8
SEQ = 8192
DEPTH = 1
DEC_BATCH = 16
DEC_SEQ = 32
PAST_LEN = 2048

CHUNK = 64
D_MIX = D_MODEL
D_POOL = D_MIX // 2
D_HG = D_MIX - D_POOL
POOL_WINDOWS = (2, 4, 8, 16)
N_POOL_GROUPS = len(POOL_WINDOWS)
POOL_GROUP = D_POOL // N_POOL_GROUPS
POOL_HIST = max(POOL_WINDOWS) - 1
HG_HEAD_DIM = 128
HG_HEADS = D_HG // HG_HEAD_DIM
D_IN = D_POOL + 4 * D_HG
D_FF = -(-8 * D_MODEL // (3 * 256)) * 256
EPS = 1e-6

kernel_name = "hymba_pool_hgrn2_stream_step"


def rmsnorm(x, g):
    xf = x.astype(jnp.float32)
    y = xf * lax.rsqrt(jnp.mean(xf * xf, axis=-1, keepdims=True) + EPS)
    return (y * g.astype(jnp.float32)).astype(x.dtype)


def pool_mix(u_ext, n_valid, w_pool, pool_scale):
    B = u_ext.shape[0]
    L = u_ext.shape[1] - POOL_HIST
    uf = u_ext.astype(jnp.float32)
    csum = jnp.concatenate([jnp.zeros_like(uf[:, :1]), jnp.cumsum(uf, axis=1)], axis=1)
    u_cur = uf[:, POOL_HIST:]
    t = jnp.arange(L, dtype=jnp.float32)
    outs = []
    for g, w in enumerate(POOL_WINDOWS):
        sl = slice(g * POOL_GROUP, (g + 1) * POOL_GROUP)
        hi = csum[:, POOL_HIST + 1:, sl]
        lo = csum[:, POOL_HIST + 1 - w:POOL_HIST + 1 - w + L, sl]
        count = jnp.minimum(t + 1.0 + n_valid, float(w))
        outs.append((hi - lo) / count[None, :, None] - u_cur[:, :, sl])
    d = jnp.stack(outs, axis=2)
    y = jnp.einsum('blgc,gcd->blgd', d, w_pool.astype(jnp.float32)).reshape(B, L, D_POOL)
    return (y * pool_scale.astype(jnp.float32)).astype(u_ext.dtype)


def hgrn_chunk(S0, q, k, v, logf):
    C = q.shape[2]
    b = jnp.cumsum(logf, axis=2)
    causal = jnp.tril(jnp.ones((C, C), dtype=bool))
    diff = b[:, :, :, None, :] - b[:, :, None, :, :]
    decay = jnp.exp(jnp.where(causal[None, None, :, :, None], diff, -jnp.inf))
    attn = jnp.einsum('bhtk,bhsk,bhtsk->bhts', q, k, decay)
    o = jnp.einsum('bhts,bhsv->bhtv', attn, v) + jnp.einsum('bhtk,bhkv->bhtv', q * jnp.exp(b), S0)
    b_last = b[:, :, -1:, :]
    k_dec = k * jnp.exp(b_last - b)
    S1 = jnp.exp(b_last[:, :, 0, :])[..., None] * S0 + jnp.einsum('bhsk,bhsv->bhkv', k_dec, v)
    return S1, o


def hgrn_run(S0, q, k, v, logf):
    B, H, L, K = q.shape
    if L <= CHUNK:
        return hgrn_chunk(S0, q, k, v, logf)
    n = L // CHUNK

    def to_chunks(a):
        return a.reshape(B, H, n, CHUNK, a.shape[-1]).transpose(2, 0, 1, 3, 4)

    def step(S, xs):
        return hgrn_chunk(S, *xs)

    S_fin, o = lax.scan(step, S0, (to_chunks(q), to_chunks(k), to_chunks(v), to_chunks(logf)))
    o = o.transpose(1, 2, 0, 3, 4).reshape(B, H, L, -1)
    return S_fin, o


def to_heads(a):
    B, L, _ = a.shape
    return a.reshape(B, L, HG_HEADS, HG_HEAD_DIM).transpose(0, 2, 1, 3)


def layer(x, pool_hist, n_valid, S0, g_pre_mix, w_in, w_pool, pool_scale, lb, g_hg_norm,
          w_out, g_post_mix, g_pre_ffn, w_gate, w_up, w_down, g_post_ffn):
    B, L, _ = x.shape
    h = rmsnorm(x, g_pre_mix)
    z = h @ w_in
    u, zq, zf, zi, zg = jnp.split(z, [D_POOL, D_POOL + D_HG, D_POOL + 2 * D_HG, D_POOL + 3 * D_HG], axis=-1)
    u_ext = jnp.concatenate([pool_hist.astype(u.dtype), u], axis=1)
    y_pool = pool_mix(u_ext, n_valid, w_pool, pool_scale)
    new_pool = u_ext[:, -POOL_HIST:]
    lbf = lb.astype(jnp.float32)
    zff = zf.astype(jnp.float32)
    q = jax.nn.silu(zq.astype(jnp.float32))
    fgate = lbf + (1.0 - lbf) * jax.nn.sigmoid(zff)
    kin = (1.0 - lbf) * jax.nn.sigmoid(-zff)
    logf = jnp.log(fgate)
    S1, o = hgrn_run(S0.astype(jnp.float32), to_heads(q), to_heads(kin),
                     to_heads(zi.astype(jnp.float32)), to_heads(logf))
    o = rmsnorm(o.transpose(0, 2, 1, 3), g_hg_norm).reshape(B, L, D_HG)
    y_hg = (o * jax.nn.silu(zg.astype(jnp.float32))).astype(x.dtype)
    y_mix = jnp.concatenate([y_pool.astype(x.dtype), y_hg], axis=-1) @ w_out
    x = x + rmsnorm(y_mix, g_post_mix)
    h2 = rmsnorm(x, g_pre_ffn)
    f = (jax.nn.silu(h2 @ w_gate) * (h2 @ w_up)) @ w_down
    x = x + rmsnorm(f, g_post_ffn)
    return x, new_pool, S1


def setup_inputs(seed: int = 0) -> dict:
    key = jax.random.key(seed)
    ks = jax.random.split(key, 20)
    f32 = jnp.float32

    def nrm(k, shape, scale):
        return jax.random.normal(k, shape, f32) * scale

    return {
        "x_prompt": nrm(ks[0], (BATCH, SEQ, D_MODEL), 1.0),
        "x_sample": nrm(ks[1], (DEC_BATCH, DEC_SEQ, D_MODEL), 1.0),
        "cache_pool": nrm(ks[2], (DEPTH, DEC_BATCH, POOL_HIST, D_POOL), 1.0),
        "state_hgrn": nrm(ks[3], (DEPTH, DEC_BATCH, HG_HEADS, HG_HEAD_DIM, HG_HEAD_DIM), 0.5),
        "g_pre_mix": 1.0 + nrm(ks[4], (DEPTH, D_MODEL), 0.05),
        "w_in": nrm(ks[5], (DEPTH, D_MODEL, D_IN), D_MODEL ** -0.5),
        "w_pool": nrm(ks[6], (DEPTH, N_POOL_GROUPS, POOL_GROUP, POOL_GROUP), POOL_GROUP ** -0.5),
        "pool_scale": 1.0 + nrm(ks[7], (DEPTH, D_POOL), 0.05),
        "lb_logits": nrm(ks[8], (DEPTH + 1, D_HG), 0.5),
        "g_hg_norm": 1.0 + nrm(ks[9], (DEPTH, HG_HEAD_DIM), 0.05),
        "w_out": nrm(ks[10], (DEPTH, D_MIX, D_MODEL), D_MIX ** -0.5),
        "g_post_mix": 1.0 + nrm(ks[11], (DEPTH, D_MODEL), 0.05),
        "g_pre_ffn": 1.0 + nrm(ks[12], (DEPTH, D_MODEL), 0.05),
        "w_gate": nrm(ks[13], (DEPTH, D_MODEL, D_FF), D_MODEL ** -0.5),
        "w_up": nrm(ks[14], (DEPTH, D_MODEL, D_FF), D_MODEL ** -0.5),
        "w_down": nrm(ks[15], (DEPTH, D_FF, D_MODEL), D_FF ** -0.5),
        "g_post_ffn": 1.0 + nrm(ks[16], (DEPTH, D_MODEL), 0.05),
    }


def reference(x_prompt, x_sample, cache_pool, state_hgrn, g_pre_mix, w_in, w_pool, pool_scale,
              lb_logits, g_hg_norm, w_out, g_post_mix, g_pre_ffn, w_gate, w_up, w_down, g_post_ffn):
    lb_all = jnp.cumsum(jax.nn.softmax(lb_logits.astype(jnp.float32), axis=0), axis=0)
    xp = x_prompt
    xs = x_sample
    pools_p, hgrn_p, pools_s, hgrn_s = [], [], [], []
    for l in range(DEPTH):
        ws = (g_pre_mix[l], w_in[l], w_pool[l], pool_scale[l], lb_all[l], g_hg_norm[l], w_out[l],
              g_post_mix[l], g_pre_ffn[l], w_gate[l], w_up[l], w_down[l], g_post_ffn[l])
        hist0 = jnp.zeros((xp.shape[0], POOL_HIST, D_POOL), xp.dtype)
        S0 = jnp.zeros((xp.shape[0], HG_HEADS, HG_HEAD_DIM, HG_HEAD_DIM), jnp.float32)
        xp, np_p, S_p = layer(xp, hist0, 0, S0, *ws)
        xs, np_s, S_s = layer(xs, cache_pool[l], POOL_HIST, state_hgrn[l], *ws)
        pools_p.append(np_p)
        hgrn_p.append(S_p)
        pools_s.append(np_s)
        hgrn_s.append(S_s)
    new_pool_prompt = jnp.stack(pools_p, axis=0)
    new_hgrn_prompt = jnp.stack(hgrn_p, axis=0)
    new_pool_sample = jnp.stack(pools_s, axis=0)
    new_hgrn_sample = jnp.stack(hgrn_s, axis=0)
    return (xp, xs, new_pool_prompt, new_hgrn_prompt, new_pool_sample, new_hgrn_sample)
```

```cpp
#include <hip/hip_runtime.h>
#include <hip/hip_cooperative_groups.h>
#include <cstdio>
#include <cstdint>
namespace cg = cooperative_groups;

#define LAS __attribute__((address_space(3)))
typedef unsigned short bf16_t;
typedef short bf16x8 __attribute__((ext_vector_type(8)));
typedef short bf16x4 __attribute__((ext_vector_type(4)));
typedef float f32x4 __attribute__((ext_vector_type(4)));
typedef float f32x2 __attribute__((ext_vector_type(2)));
typedef unsigned u32x4 __attribute__((ext_vector_type(4)));
typedef unsigned u32x2 __attribute__((ext_vector_type(2)));
typedef _Float16 f16x2 __attribute__((ext_vector_type(2)));

constexpr int DM = 1024, MP = 65536, MS = 512, MT = MP + MS;
constexpr int SEQ = 8192, DSEQ = 32, NBP = 8, NBS = 16;
constexpr int DPOOL = 512, DHG = 512, DIN = 2560, DFF = 2816, NGU = 2 * DFF;
constexpr float EPS = 1e-6f;
constexpr float LOG2E = 1.4426950408889634f, LN2 = 0.6931471805599453f;
constexpr size_t OFF_Y = 0, OFF_PP = (size_t)MT * DM, OFF_HP = OFF_PP + 8 * 15 * 512, OFF_PS = OFF_HP + 8 * 4 * 16384, OFF_HS = OFF_PS + 16 * 15 * 512;
constexpr size_t MiB = 1u << 20;
constexpr size_t WS_CTL = 0, CTL_ZERO_BYTES = 65536;
constexpr size_t WS_WIN = 2 * MiB;
constexpr size_t WS_WOUT = 8 * MiB;
constexpr size_t WS_WGU = 10 * MiB;
constexpr size_t WS_WD = 22 * MiB;
constexpr size_t WS_WP = 28 * MiB;
constexpr size_t WS_LB = 29 * MiB;
constexpr size_t WS_LD = 30 * MiB;
constexpr size_t WS_SLOC = 32 * MiB;
constexpr int TROWS = MP / 2 + MS;
__host__ __device__ constexpr int nsp_of(int team) { return team == 0 ? 2 : 0; }
__host__ __device__ constexpr int trows_of(int team) { return MP / 2 + 256 * nsp_of(team); }
constexpr size_t WS_TEAM = 64 * MiB, TEAM_BYTES = 480 * MiB;
constexpr size_t T_A = 0;
constexpr size_t T_C = 65 * MiB;
constexpr size_t T_SS = 130 * MiB;
constexpr size_t T_RS0 = T_SS + (size_t)(2.25 * 1048576);
constexpr size_t T_RS2 = T_SS + (size_t)(2.50 * 1048576);
constexpr size_t T_B = 133 * MiB;
constexpr size_t PART_B = (size_t)TROWS * 512 * 2;
constexpr size_t T_U = T_B, T_Q = T_B + PART_B, T_KIN = T_B + 2 * PART_B, T_V = T_B + 3 * PART_B, T_SG = T_B + 4 * PART_B, T_LOGF = T_B + 5 * PART_B;
constexpr size_t T_ACT = T_B;
constexpr size_t T_END = T_LOGF + (size_t)TROWS * 512 * 2;
constexpr size_t T_X1 = 328 * MiB;
constexpr size_t T_SLAB = 393 * MiB;
constexpr size_t T_XB = 405 * MiB;
constexpr size_t T_SLAB5 = T_XB;
constexpr size_t WS_END = WS_TEAM + 2 * TEAM_BYTES;
static_assert(T_END <= T_X1 && T_X1 + (size_t)TROWS * 2048 <= T_SLAB && T_SLAB + (size_t)2 * 4 * 256 * 1024 * 4 <= T_XB && T_XB + (size_t)TROWS * 2048 <= TEAM_BYTES && T_ACT + (size_t)TROWS * DFF * 2 <= T_END &&
              (size_t)2 * 11 * 256 * 1024 * 4 <= (size_t)TROWS * 2048 &&
              WS_END <= 1024 * MiB && T_A + (size_t)TROWS * 2048 <= T_C && T_C + (size_t)TROWS * 2048 <= T_SS && T_SS + (size_t)TROWS * 64 <= T_RS0 && T_RS2 + (size_t)TROWS * 4 <= T_B, "ws map");

__device__ __forceinline__ unsigned cvt_pk_bf16(float lo, float hi) { unsigned r; asm volatile("v_cvt_pk_bf16_f32 %0, %1, %2" : "=v"(r) : "v"(lo), "v"(hi)); return r; }
__device__ __forceinline__ unsigned pk_f16(float lo, float hi) { const f16x2 h = (f16x2){(_Float16)lo, (_Float16)hi}; return __builtin_bit_cast(unsigned, h); }
__device__ __forceinline__ f32x2 unpk_f16(unsigned u) { const f16x2 h = __builtin_bit_cast(f16x2, u); return (f32x2){(float)h.x, (float)h.y}; }
__device__ __forceinline__ float bf_lo(unsigned u) { return __builtin_bit_cast(float, u << 16); }
__device__ __forceinline__ float bf_hi(unsigned u) { return __builtin_bit_cast(float, u & 0xffff0000u); }
__device__ __forceinline__ float fexp2(float x) { return __builtin_amdgcn_exp2f(x); }
__device__ __forceinline__ float flog2(float x) { return __builtin_amdgcn_logf(x); }
__device__ __forceinline__ float frcp(float x) { return __builtin_amdgcn_rcpf(x); }
__device__ __forceinline__ float fsigmoid(float x) { return frcp(1.0f + fexp2(-LOG2E * x)); }
__device__ __forceinline__ float fsilu(float x) { return x * fsigmoid(x); }
__device__ __forceinline__ float wave_sum(float v) {
#pragma unroll
    for (int o = 1; o < 64; o <<= 1) v += __shfl_xor(v, o);
    return v;
}

namespace pg8 {
#define PG8_LAS __attribute__((address_space(3)))
constexpr int BM = 256, BK = 64, HALF = 128, HTB = HALF * BK * 2, STAGE_BYTES = 8 * HTB, NXT = 4  , WGM = 8;
constexpr int NPP = 256  , TPP = 128  ;
__host__ __device__ __forceinline__ int lds_byte(int r, int c) { const int st = (r >> 4) * 2 + (c >> 5), rr = r & 15, cc = c & 31, ob = rr * 64 + cc * 2; return st * 1024 + (ob ^ (((ob >> 9) & 1) << 5)); }
__host__ __device__ __forceinline__ void stage_rc(int b, int& R, int& C) { const int st = b / 1024, sb = b % 1024, swz = sb ^ (((sb >> 9) & 1) << 5); R = (st >> 1) * 16 + swz / 64; C = (st & 1) * 32 + (swz % 64) / 2; }
__host__ __device__ __forceinline__ int perm32(int rho) { const int n = rho >> 4, i = rho & 15; return 8 * (i >> 2) + 4 * n + (i & 3); }
struct Unit { int pm, pn, kt0, nkt, slab; };
struct Gemm { const bf16_t* A; const bf16_t* Bt; int M, N, K; };
struct StaticOrder {
    int nM, nN, nwg, G, c, nsl, nkt, nsp;
    __host__ __device__ void init(int nM_, int N, int K, int G_, int c_, int nsl_, int nsp_ = 0) { nM = nM_; nN = N / BM; nwg = nM * nN; G = G_; c = c_; nsl = nsl_; nkt = K / BK; nsp = nsp_; }
    __host__ __device__ bool next(int i, Unit& u) const {
        const long L = (long)i * G + c;
        if (L >= nwg) { int s = (int)(L - nwg); if (s >= nsp * nsl * nN) return false;
            const int sp = s / (nsl * nN); s -= sp * nsl * nN;
            u.pm = 128 + sp; u.pn = s % nN; u.kt0 = 4 * (s / nN); u.nkt = 4; u.slab = 1 + sp * nsl + s / nN; return true; }
        int wgid = (int)L; { const int q = nwg / NXT, r = nwg % NXT, xcd = wgid % NXT, off = wgid / NXT; wgid = (xcd < r ? xcd * (q + 1) : r * (q + 1) + (xcd - r) * q) + off; }
        const int nig = WGM * nN, gid = wgid / nig, fm = gid * WGM, gsz = (nM - fm) < WGM ? (nM - fm) : WGM;
        u.pm = fm + ((wgid % nig) % gsz);
        u.pn = (wgid % nig) / gsz; u.kt0 = 0; u.nkt = nkt; u.slab = 0; return true;
    }
    __device__ __forceinline__ void a_ready(const Unit&) const {}
    __device__ __forceinline__ void done(const Unit&) const {}
};

constexpr int EPI_STG_OFF = 131072 + 256, EPI_STG_WAVE = 16 * 144;
__device__ __forceinline__ void store_lines16(PG8_LAS unsigned char* T, const u32x4& w0, const u32x4& w1, bf16_t* dst, size_t pitch, int fr, int fq) {
    *(PG8_LAS u32x4*)(T + fr * 144 + 16 * fq) = w0; *(PG8_LAS u32x4*)(T + fr * 144 + 64 + 16 * fq) = w1;
    asm volatile("" ::: "memory");
    const int l = fq * 16 + fr, rr = l >> 3, ch = l & 7;
    const u32x4 a = *(const PG8_LAS u32x4*)(T + rr * 144 + 16 * ch), b = *(const PG8_LAS u32x4*)(T + (rr + 8) * 144 + 16 * ch);
    asm volatile("" ::: "memory");
    *(u32x4*)(dst + (size_t)rr * pitch + 8 * ch) = a; *(u32x4*)(dst + (size_t)(rr + 8) * pitch + 8 * ch) = b;
}

struct EpiZ {
    static constexpr bool PERM = true, AFTER_DRAIN = false;
    unsigned char* tws; const float* LB; PG8_LAS unsigned char* stg;
    __device__ __forceinline__ void operator()(const f32x4 (&acc)[2][2][4][2], const Unit& u, int wr, int wc, int fr, int fq) const {
        bf16_t* const U = (bf16_t*)(tws + T_U); bf16_t* const Q = (bf16_t*)(tws + T_Q); bf16_t* const V = (bf16_t*)(tws + T_V); bf16_t* const SG = (bf16_t*)(tws + T_SG);
        bf16_t* const LOGF = (bf16_t*)(tws + T_LOGF);
        PG8_LAS unsigned char* T = stg + (wr * 4 + wc) * EPI_STG_WAVE;
        const int rowg = u.pm * BM + wr * 64;
        const int type = u.pn >> 1;
        const int colw = (u.pn & 1) * 256 + wc * 64;
        if (type == 2) {
            f32x4 lbv[2][2];
#pragma unroll
            for (int bj = 0; bj < 2; ++bj) { lbv[bj][0] = *(const f32x4*)(LB + colw + bj * 32 + 8 * fq); lbv[bj][1] = *(const f32x4*)(LB + colw + bj * 32 + 8 * fq + 4); }
#pragma unroll
            for (int ai = 0; ai < 2; ++ai)
#pragma unroll
                for (int m = 0; m < 4; ++m) { const size_t ro = (size_t)(rowg + ai * HALF + m * 16) * 512 + colw;
                    u32x4 lw[2];
#pragma unroll
                    for (int bj = 0; bj < 2; ++bj) { f32x4 lf[2];
#pragma unroll
                        for (int n = 0; n < 2; ++n)
#pragma unroll
                            for (int e = 0; e < 4; ++e) { const float z = acc[ai][bj][m][n][e], lb = lbv[bj][n][e], s = fsigmoid(z), oml = 1.0f - lb;
                                lf[n][e] = flog2(lb + oml * s); }
                        lw[bj].x = pk_f16(lf[0][0], lf[0][1]); lw[bj].y = pk_f16(lf[0][2], lf[0][3]); lw[bj].z = pk_f16(lf[1][0], lf[1][1]); lw[bj].w = pk_f16(lf[1][2], lf[1][3]); }
                    store_lines16(T, lw[0], lw[1], LOGF + ro, 512, fr, fq);
                    asm volatile("" ::: "memory"); }
        } else {
            bf16_t* O = type == 0 ? U : (type == 1 ? Q : (type == 3 ? V : SG));
            const bool act = (type == 1) || (type == 4);
#pragma unroll
            for (int ai = 0; ai < 2; ++ai)
#pragma unroll
                for (int m = 0; m < 4; ++m) { const size_t ro = (size_t)(rowg + ai * HALF + m * 16) * 512 + colw;
                    u32x4 w[2];
#pragma unroll
                    for (int bj = 0; bj < 2; ++bj) { f32x4 v0 = acc[ai][bj][m][0], v1 = acc[ai][bj][m][1];
                        if (act) {
#pragma unroll
                            for (int e = 0; e < 4; ++e) { v0[e] = fsilu(v0[e]); v1[e] = fsilu(v1[e]); } }
                        w[bj].x = cvt_pk_bf16(v0[0], v0[1]); w[bj].y = cvt_pk_bf16(v0[2], v0[3]); w[bj].z = cvt_pk_bf16(v1[0], v1[1]); w[bj].w = cvt_pk_bf16(v1[2], v1[3]); }
                    store_lines16(T, w[0], w[1], O + ro, 512, fr, fq);
                    asm volatile("" ::: "memory"); }
        }
    }
};
struct EpiAct {
    static constexpr bool PERM = true, AFTER_DRAIN = false;
    bf16_t* ACT;
    __device__ __forceinline__ void operator()(const f32x4 (&acc)[2][2][4][2], const Unit& u, int wr, int wc, int fr, int fq) const {
        const int kt = u.pn * 2 + (wc >> 1);
        const int ob = fr * 64 + fq * 16, inb = ob ^ (((ob >> 9) & 1) << 5);
#pragma unroll
        for (int ai = 0; ai < 2; ++ai)
#pragma unroll
            for (int m = 0; m < 4; ++m) {
                unsigned char* p = (unsigned char*)ACT + ((size_t)(u.pm * 2 + ai) * (DFF / 64) + kt) * 16384 + ((wr * 4 + m) * 2 + (wc & 1)) * 1024 + inb;
                f32x4 a0, a1;
#pragma unroll
                for (int e = 0; e < 4; ++e) {
                    a0[e] = (acc[ai][0][m][0][e] * acc[ai][1][m][0][e]) * frcp(1.0f + fexp2(acc[ai][0][m][0][e]));
                    a1[e] = (acc[ai][0][m][1][e] * acc[ai][1][m][1][e]) * frcp(1.0f + fexp2(acc[ai][0][m][1][e])); }
                u32x4 w; w.x = cvt_pk_bf16(a0[0], a0[1]); w.y = cvt_pk_bf16(a0[2], a0[3]); w.z = cvt_pk_bf16(a1[0], a1[1]); w.w = cvt_pk_bf16(a1[2], a1[3]);
                *(u32x4*)p = w; }
    }
};
struct EpiRow {
    static constexpr bool PERM = true, AFTER_DRAIN = false;
    bf16_t* O; float* SS; float* SLAB; PG8_LAS unsigned char* stg;
    __device__ __forceinline__ void operator()(const f32x4 (&acc)[2][2][4][2], const Unit& u, int wr, int wc, int fr, int fq) const {
        if (u.slab) {
            float* base = SLAB + (size_t)(u.slab - 1) * 256 * DM + u.pn * BM + wc * 64 + 8 * fq;
#pragma unroll
            for (int ai = 0; ai < 2; ++ai)
#pragma unroll
                for (int m = 0; m < 4; ++m) { float* p = base + (size_t)(wr * 64 + fr + ai * HALF + m * 16) * DM;
#pragma unroll
                    for (int bj = 0; bj < 2; ++bj) { *(f32x4*)(p + bj * 32) = acc[ai][bj][m][0]; *(f32x4*)(p + bj * 32 + 4) = acc[ai][bj][m][1]; }
                    asm volatile("" ::: "memory"); }
            return;
        }
        PG8_LAS unsigned char* T = stg + (wr * 4 + wc) * EPI_STG_WAVE;
        const int rowg = u.pm * BM + wr * 64, colw = u.pn * BM + wc * 64;
#pragma unroll
        for (int ai = 0; ai < 2; ++ai)
#pragma unroll
            for (int m = 0; m < 4; ++m) { const int row = rowg + ai * HALF + m * 16; float s = 0.f; u32x4 w[2];
#pragma unroll
                for (int bj = 0; bj < 2; ++bj) { const f32x4 v0 = acc[ai][bj][m][0], v1 = acc[ai][bj][m][1];
                    s += (v0[0] * v0[0] + v0[1] * v0[1]) + (v0[2] * v0[2] + v0[3] * v0[3]) + (v1[0] * v1[0] + v1[1] * v1[1]) + (v1[2] * v1[2] + v1[3] * v1[3]);
                    w[bj].x = cvt_pk_bf16(v0[0], v0[1]); w[bj].y = cvt_pk_bf16(v0[2], v0[3]); w[bj].z = cvt_pk_bf16(v1[0], v1[1]); w[bj].w = cvt_pk_bf16(v1[2], v1[3]); }
                store_lines16(T, w[0], w[1], O + (size_t)row * DM + colw, DM, fr, fq);
                s += __shfl_xor(s, 16); s += __shfl_xor(s, 32);
                if (fq == 0) SS[(size_t)(row >> 4) * 256 + (u.pn * 4 + wc) * 16 + fr] = s; }
    }
};

template <class Epi, class Sched, bool ALIGN_EPI = false, bool SP2 = false, bool ATILED = false>
__device__ __forceinline__ void gemm_phase(PG8_LAS unsigned char* lds, const Gemm g, const Sched& S, const Epi& E) {
    int tid = threadIdx.x; asm volatile("" : "+v"(tid));
    const int wid = __builtin_amdgcn_readfirstlane(tid >> 6), lane = tid & 63, wr = wid >> 2, wc = wid & 3, fr = lane & 15, fq = lane >> 4;
    const int K = g.K;
    unsigned voffA[2], voffB[2];
#pragma unroll
    for (int i = 0; i < 2; ++i) { int R, C; stage_rc(tid * 16 + i * 8192, R, C);
        voffA[i] = ATILED ? (unsigned)(tid * 16 + i * 8192) : (unsigned)(R * K + C) * 2u; voffB[i] = (unsigned)(tid * 16 + i * 8192); }
    const size_t kstep = ATILED ? (size_t)16384 : (size_t)(BK * 2);
    const size_t hstep = ATILED ? (size_t)(K / BK) * 16384 : (size_t)HALF * K * 2;
    const size_t kstepB = 16384, qstep = (size_t)(K / BK) * 16384, tstepB = 2 * qstep;
    const size_t tstep = 2 * hstep;
    const unsigned ldsw = (unsigned)wid * 1024u;
    const int aoff = lds_byte(wr * 64 + fr, fq * 8), boff = lds_byte(wc * 32 + fr, fq * 8);
#define PG8_SA(b, h) (((b) * 2 + (h)) * HTB)
#define PG8_SB(b, h) ((4 + (b) * 2 + (h)) * HTB)
#define PG8_STAGE(bufoff, gbase, voff) do { _Pragma("unroll") for (int _i = 0; _i < 2; ++_i) \
        __builtin_amdgcn_global_load_lds((const unsigned*)((const char*)(gbase) + (voff)[_i]), (PG8_LAS unsigned*)(lds + (bufoff) + ldsw + _i * 8192), 16, 0, 0); } while (0)
#define PG8_LDA(dst, b, h) do { _Pragma("unroll") for (int m = 0; m < 4; ++m) _Pragma("unroll") for (int k = 0; k < 2; ++k) dst[m][k] = *(const PG8_LAS bf16x8*)(lds + PG8_SA(b, h) + aoff + m * 2048 + k * 1024); } while (0)
#define PG8_LDB(dst, b, h) do { _Pragma("unroll") for (int n = 0; n < 2; ++n) _Pragma("unroll") for (int k = 0; k < 2; ++k) dst[n][k] = *(const PG8_LAS bf16x8*)(lds + PG8_SB(b, h) + boff + n * 2048 + k * 1024); } while (0)
#define PG8_MMA(ai, bj, At, Bt) do { __builtin_amdgcn_s_setprio(1); _Pragma("unroll") for (int m = 0; m < 4; ++m) _Pragma("unroll") for (int n = 0; n < 2; ++n) _Pragma("unroll") for (int k = 0; k < 2; ++k) \
        acc[ai][bj][m][n] = __builtin_amdgcn_mfma_f32_16x16x32_bf16(Bt[n][k], At[m][k], acc[ai][bj][m][n], 0, 0, 0); __builtin_amdgcn_s_setprio(0); } while (0)
#define PG8_WAIT_V(n) asm volatile("s_waitcnt vmcnt(" #n ")" ::: "memory")
#define PG8_WAIT_L(n) asm volatile("s_waitcnt lgkmcnt(" #n ")" ::: "memory")
#define PG8_BAR __builtin_amdgcn_s_barrier()
#define PG8_SCHED __builtin_amdgcn_sched_barrier(0)
    Unit cur, nxt; int ui = 0;
    if (!S.next(0, cur)) return;
    f32x4 acc[2][2][4][2];
#pragma unroll
    for (int a = 0; a < 2; ++a)
#pragma unroll
        for (int b = 0; b < 2; ++b)
#pragma unroll
            for (int m = 0; m < 4; ++m)
#pragma unroll
                for (int n = 0; n < 2; ++n) acc[a][b][m][n] = (f32x4){0.f, 0.f, 0.f, 0.f};
    bf16x8 At[4][2], B0[2][2], B1[2][2];
    const char* cA = (const char*)g.A + (size_t)cur.pm * tstep + (size_t)cur.kt0 * kstep; const char* cB = (const char*)g.Bt + (size_t)cur.pn * tstepB + (size_t)cur.kt0 * kstepB;
    S.a_ready(cur);
    if constexpr (SP2) {
        PG8_STAGE(PG8_SB(0, 0), cB, voffB); PG8_STAGE(PG8_SB(0, 1), cB + qstep, voffB); PG8_STAGE(PG8_SA(0, 0), cA, voffA); PG8_STAGE(PG8_SA(0, 1), cA + hstep, voffA);
        if (wr == 1) PG8_BAR;
        PG8_WAIT_V(2); PG8_BAR;
        PG8_STAGE(PG8_SB(1, 0), cB + kstepB, voffB); PG8_STAGE(PG8_SA(1, 0), cA + kstep, voffA); PG8_STAGE(PG8_SB(1, 1), cB + qstep + kstepB, voffB);
        PG8_WAIT_V(6); PG8_BAR;
    } else {
        PG8_STAGE(PG8_SB(0, 0), cB, voffB); PG8_STAGE(PG8_SA(0, 0), cA, voffA); PG8_STAGE(PG8_SB(0, 1), cB + qstep, voffB); PG8_STAGE(PG8_SA(0, 1), cA + hstep, voffA);
        if (wr == 1) PG8_BAR;
        PG8_WAIT_V(4); PG8_BAR;
        PG8_STAGE(PG8_SB(1, 0), cB + kstepB, voffB); PG8_STAGE(PG8_SA(1, 0), cA + kstep, voffA); PG8_STAGE(PG8_SB(1, 1), cB + qstep + kstepB, voffB);
        PG8_WAIT_V(6); PG8_BAR;
    }
    for (;;) {
        const bool has_next = S.next(ui + 1, nxt);
        const char* nA = has_next ? (const char*)g.A + (size_t)nxt.pm * tstep + (size_t)nxt.kt0 * kstep : cA; const char* nB = has_next ? (const char*)g.Bt + (size_t)nxt.pn * tstepB + (size_t)nxt.kt0 * kstepB : cB;
        const int nt = cur.nkt;
        for (int t = 0; t < nt; t += 2) {
            const bool last = (t == nt - 2);
            const char* a1 = cA + (size_t)(t + 1) * kstep;
            const char* a2 = last ? nA : cA + (size_t)(t + 2) * kstep; const char* b2 = last ? nB : cB + (size_t)(t + 2) * kstepB;
            const char* a3 = a2 + kstep; const char* b3 = b2 + kstepB;
            if (last && has_next) S.a_ready(nxt);
            if constexpr (SP2) {
            PG8_LDB(B0, 0, 0); PG8_LDB(B1, 0, 1); PG8_SCHED; PG8_LDA(At, 0, 0); PG8_STAGE(PG8_SA(1, 1), a1 + hstep, voffA);
            PG8_WAIT_V(8); PG8_WAIT_L(0); PG8_BAR; PG8_MMA(0, 0, At, B0); PG8_MMA(0, 1, At, B1); PG8_BAR; PG8_SCHED;
            PG8_LDA(At, 0, 1); PG8_STAGE(PG8_SB(0, 0), b2, voffB); PG8_STAGE(PG8_SB(0, 1), b2 + qstep, voffB); PG8_STAGE(PG8_SA(0, 0), a2, voffA);
            PG8_WAIT_V(8); PG8_WAIT_L(0); PG8_BAR; PG8_MMA(1, 0, At, B0); PG8_MMA(1, 1, At, B1); PG8_BAR; PG8_SCHED;
            PG8_LDB(B0, 1, 0); PG8_LDB(B1, 1, 1); PG8_SCHED; PG8_LDA(At, 1, 0); PG8_STAGE(PG8_SA(0, 1), a2 + hstep, voffA);
            PG8_WAIT_V(8); PG8_WAIT_L(0); PG8_BAR; PG8_MMA(0, 0, At, B0); PG8_MMA(0, 1, At, B1); PG8_BAR; PG8_SCHED;
            PG8_LDA(At, 1, 1); PG8_STAGE(PG8_SB(1, 0), b3, voffB); PG8_STAGE(PG8_SB(1, 1), b3 + qstep, voffB); PG8_STAGE(PG8_SA(1, 0), a3, voffA);
            PG8_WAIT_V(8); PG8_WAIT_L(0); PG8_BAR; PG8_MMA(1, 0, At, B0); PG8_MMA(1, 1, At, B1); PG8_BAR; PG8_SCHED;
            } else {
            PG8_LDB(B0, 0, 0); PG8_SCHED; PG8_LDA(At, 0, 0); PG8_STAGE(PG8_SA(1, 1), a1 + hstep, voffA);
            PG8_WAIT_L(8); PG8_BAR; PG8_WAIT_L(0); PG8_MMA(0, 0, At, B0); PG8_BAR; PG8_SCHED;
            PG8_LDB(B1, 0, 1); PG8_STAGE(PG8_SB(0, 0), b2, voffB);
            PG8_BAR; PG8_WAIT_L(0); PG8_MMA(0, 1, At, B1); PG8_BAR;
            PG8_LDA(At, 0, 1); PG8_STAGE(PG8_SA(0, 0), a2, voffA);
            PG8_BAR; PG8_WAIT_L(0); PG8_MMA(1, 0, At, B0); PG8_BAR; PG8_SCHED;
            PG8_STAGE(PG8_SB(0, 1), b2 + qstep, voffB);
            PG8_WAIT_V(6); PG8_BAR; PG8_MMA(1, 1, At, B1); PG8_BAR;
            PG8_LDB(B0, 1, 0); PG8_SCHED; PG8_LDA(At, 1, 0); PG8_STAGE(PG8_SA(0, 1), a2 + hstep, voffA);
            PG8_WAIT_L(8); PG8_BAR; PG8_WAIT_L(0); PG8_MMA(0, 0, At, B0); PG8_BAR; PG8_SCHED;
            PG8_LDB(B1, 1, 1); PG8_STAGE(PG8_SB(1, 0), b3, voffB);
            PG8_BAR; PG8_WAIT_L(0); PG8_MMA(0, 1, At, B1); PG8_BAR;
            PG8_LDA(At, 1, 1); PG8_STAGE(PG8_SA(1, 0), a3, voffA);
            PG8_BAR; PG8_WAIT_L(0); PG8_MMA(1, 0, At, B0); PG8_BAR; PG8_SCHED;
            PG8_STAGE(PG8_SB(1, 1), b3 + qstep, voffB);
            PG8_WAIT_V(6); PG8_BAR; PG8_MMA(1, 1, At, B1); PG8_BAR;
            }
        }
        if constexpr (ALIGN_EPI) { if (wr == 0) PG8_BAR; }
        if constexpr (!Epi::AFTER_DRAIN) { E(acc, cur, wr, wc, fr, fq); S.done(cur); }
        if (!has_next) break;
#pragma unroll
        for (int a = 0; a < 2; ++a)
#pragma unroll
            for (int b = 0; b < 2; ++b)
#pragma unroll
                for (int m = 0; m < 4; ++m)
#pragma unroll
                    for (int n = 0; n < 2; ++n) acc[a][b][m][n] = (f32x4){0.f, 0.f, 0.f, 0.f};
        cur = nxt; cA = nA; cB = nB; ++ui;
        if constexpr (ALIGN_EPI) { if (wr == 1) PG8_BAR; }
    }
    PG8_WAIT_V(0);
    if constexpr (!ALIGN_EPI) { if (wr == 0) PG8_BAR; }
    PG8_BAR;
#undef PG8_SA
#undef PG8_SB
#undef PG8_STAGE
#undef PG8_LDA
#undef PG8_LDB
#undef PG8_MMA
#undef PG8_WAIT_V
#undef PG8_WAIT_L
#undef PG8_BAR
#undef PG8_SCHED
}
}

struct Args {
    const float* in[17];
    float* out; unsigned char* ws;
};
static_assert(sizeof(Args) == 19 * 8, "no padding");
typedef const __attribute__((address_space(4))) Args* ArgP;
__device__ __forceinline__ ArgP get_args() { ArgP p = (ArgP)__builtin_amdgcn_kernarg_segment_ptr(); asm volatile("" : "+s"(p)); return p; }
__device__ __forceinline__ int opaque_tid() { int t = threadIdx.x; asm volatile("" : "+v"(t)); return t; }
enum { I_XP = 0, I_XS, I_CACHE, I_STATE, I_GPRE, I_WIN, I_WPOOL, I_PSCALE, I_LBL, I_GHG, I_WOUT, I_GPOST, I_GPFFN, I_WG, I_WU, I_WD, I_GPOSTF };

constexpr int LDS_BYTES = 151552;

template <int MODE>
__device__ __forceinline__ void transpose_item(const float* W, int K, int N, bf16_t* WT, LAS float* scr, int item, int lane, const float* gk = nullptr) {
    const int nblk = N / 32, kb = item / nblk, nb = item % nblk, k0 = 64 * kb, n0 = 32 * nb;
    {
        const int rr = lane >> 3, cc = lane & 7;
        f32x4 v[8];
#pragma unroll
        for (int i = 0; i < 8; ++i) v[i] = *(const f32x4*)(W + (size_t)(k0 + 8 * i + rr) * N + n0 + 4 * cc);
#pragma unroll
        for (int i = 0; i < 8; ++i) { const int kk = 8 * i + rr; const float gs = (gk ? gk[k0 + kk] : 1.0f) * (MODE == 1 ? -LOG2E : (MODE == 2 ? -LN2 : 1.0f));
            scr[kk * 33 + 4 * cc + 0] = v[i].x * gs; scr[kk * 33 + 4 * cc + 1] = v[i].y * gs; scr[kk * 33 + 4 * cc + 2] = v[i].z * gs; scr[kk * 33 + 4 * cc + 3] = v[i].w * gs; }
    }
    asm volatile("s_waitcnt lgkmcnt(0)" ::: "memory");
    const int c = lane & 7;
#pragma unroll
    for (int j = 0; j < 4; ++j) { const int n = (lane >> 3) + 8 * j; const LAS float* s = scr + (8 * c) * 33 + n;
        u32x4 o; o.x = cvt_pk_bf16(s[0 * 33], s[1 * 33]); o.y = cvt_pk_bf16(s[2 * 33], s[3 * 33]); o.z = cvt_pk_bf16(s[4 * 33], s[5 * 33]); o.w = cvt_pk_bf16(s[6 * 33], s[7 * 33]);
        if (MODE == 3) { *(u32x4*)(WT + (size_t)(n0 + n) * K + k0 + 8 * c) = o; }
        else {
            int pn, w, h;
            if (MODE == 0) { pn = n0 >> 8; w = (n0 >> 6) & 3; h = (n0 >> 5) & 1; }
            else { pn = n0 >> 7; w = (n0 >> 5) & 3; h = MODE - 1; }
            const int R = 32 * w + 16 * ((n >> 2) & 1) + ((n >> 3) << 2) + (n & 3);
            unsigned char* img = (unsigned char*)WT + ((size_t)(pn * 2 + h) * (K / 64) + kb) * 16384;
            *(u32x4*)(img + pg8::lds_byte(R, 8 * c)) = o;
        }
    }
    asm volatile("s_waitcnt lgkmcnt(0)" ::: "memory");
}
__device__ __forceinline__ const float* xrow_ptr(const float* xp, const float* xs, int m) { return m < MP ? xp + (size_t)m * DM : xs + (size_t)(m - MP) * DM; }

__device__ __forceinline__ int team_row(int t, int r) { return r < MP / 2 ? t * (MP / 2) + r : MP + (r - MP / 2); }
__device__ __forceinline__ int team_panel(int t, int p) { return p < 128 ? t * 128 + p : 256 + t; }

template <int PART>
__device__ __forceinline__ void p0_weights(ArgP ap, LAS unsigned char* lds, int tid, int wave, int lane, int gw, int NGW) {
    unsigned char* ws = ap->ws;
    LAS float* scr = (LAS float*)(lds + wave * 16384);
    constexpr int I_IN = 16 * 80, I_OUT = 16 * 32, I_G = 16 * 88, I_D = 44 * 32, I_P = 8;
    if (PART == 0) {
        constexpr int NITEMS = I_IN + I_OUT + 4 * I_P;
        for (int it = gw; it < NITEMS; it += NGW) {
            int r = it;
            if (r < I_IN) { transpose_item<0>(ap->in[I_WIN], DM, DIN, (bf16_t*)(ws + WS_WIN), scr, r, lane); continue; } r -= I_IN;
            if (r < I_OUT) { transpose_item<0>(ap->in[I_WOUT], DM, DM, (bf16_t*)(ws + WS_WOUT), scr, r, lane); continue; } r -= I_OUT;
            { const int g = r / I_P; transpose_item<3>(ap->in[I_WPOOL] + g * 16384, 128, 128, (bf16_t*)(ws + WS_WP) + g * 16384, scr, r % I_P, lane); }
        }
        if (blockIdx.x == 0) {
            const float l0 = ap->in[I_LBL][tid], l1 = ap->in[I_LBL][512 + tid];
            ((float*)(ws + WS_LB))[tid] = frcp(1.0f + fexp2((l1 - l0) * LOG2E));
        }
    } else {
        constexpr int NITEMS = 2 * I_G + I_D;
        for (int it = gw; it < NITEMS; it += NGW) {
            int r = it;
            if (r < I_G) { transpose_item<1>(ap->in[I_WG], DM, DFF, (bf16_t*)(ws + WS_WGU), scr, r, lane, ap->in[I_GPFFN]); continue; } r -= I_G;
            if (r < I_G) { transpose_item<2>(ap->in[I_WU], DM, DFF, (bf16_t*)(ws + WS_WGU), scr, r, lane, ap->in[I_GPFFN]); continue; } r -= I_G;
            transpose_item<0>(ap->in[I_WD], DFF, DM, (bf16_t*)(ws + WS_WD), scr, r, lane);
        }
    }
}
constexpr int RW = 4;
static_assert(TROWS % RW == 0 && (MP / 2) % RW == 0, "rows per wave step");
__device__ __forceinline__ void p0_xn(ArgP ap, int t, int gw, int NGW, int lane) {
    unsigned char* tw = ap->ws + WS_TEAM + (size_t)t * TEAM_BYTES;
    bf16_t* XB = (bf16_t*)(tw + T_XB); float* RS0 = (float*)(tw + T_RS0);
    const float* xp = ap->in[I_XP]; const float* xs = ap->in[I_XS];
    f32x4 gv[4];
#pragma unroll
    for (int j = 0; j < 4; ++j) gv[j] = ((const f32x4*)ap->in[I_GPRE] + lane)[64 * j];
    for (int r0 = gw * RW; r0 < trows_of(t); r0 += NGW * RW) {
        f32x4 v[RW][4];
#pragma unroll
        for (int i = 0; i < RW; ++i) { const f32x4* xr = (const f32x4*)xrow_ptr(xp, xs, team_row(t, r0 + i)) + lane;
#pragma unroll
            for (int j = 0; j < 4; ++j) v[i][j] = xr[64 * j]; }
#pragma unroll
        for (int i = 0; i < RW; ++i) { float s = 0.f;
#pragma unroll
            for (int j = 0; j < 4; ++j) s += (v[i][j].x * v[i][j].x + v[i][j].y * v[i][j].y) + (v[i][j].z * v[i][j].z + v[i][j].w * v[i][j].w);
            const float rs = 1.0f / sqrtf(wave_sum(s) * (1.0f / DM) + EPS);
            if (lane == 0) RS0[r0 + i] = rs;
            u32x2* o8 = (u32x2*)(XB + (size_t)(r0 + i) * DM) + lane;
#pragma unroll
            for (int j = 0; j < 4; ++j) { u32x2 w; w.x = cvt_pk_bf16(v[i][j].x * rs * gv[j].x, v[i][j].y * rs * gv[j].y); w.y = cvt_pk_bf16(v[i][j].z * rs * gv[j].z, v[i][j].w * rs * gv[j].w); o8[64 * j] = w; } }
    }
}
__device__ __forceinline__ float sum16(float v) { v += __shfl_xor(v, 1); v += __shfl_xor(v, 2); v += __shfl_xor(v, 4); v += __shfl_xor(v, 8); return v; }

constexpr int H_QT = 0;
constexpr int H_KT = 17408;
constexpr int H_KD = 34816;
constexpr int H_VT = 53248;
constexpr int H_AM = 71680;
constexpr int H_PART = 80896;
constexpr int H_DEC = 84992;
constexpr int H_EBR = 85504;
constexpr int H_SSQ = 86016;
constexpr int H_DECS = 90112;
constexpr int H_GT = 90112 + 7 * 512;
constexpr int H_YT = H_GT + 64 * 272;
constexpr int H_GHG = H_YT + 64 * 272;
constexpr int H_END = H_GHG + 512;
static_assert(H_END <= 131072, "hgrn lds");
#define LDS_BAR() do { asm volatile("s_waitcnt lgkmcnt(0)" ::: "memory"); __builtin_amdgcn_s_barrier(); asm volatile("" ::: "memory"); } while (0)

struct HgrnIO {
    const unsigned* Q; const unsigned* V; const unsigned* SG;
    const unsigned* LOGF;
    bf16_t* YCAT; const float* ghg;
};
enum { HM_LOCAL = 0, HM_SAMPLE = 2, HM_FINAL = 3 };
struct HRaw { unsigned lf[8], qq[8], vv[8]; };
template <int MODE, int NTOK>
__device__ __forceinline__ void hg_load(HRaw& R, const HgrnIO& io, int crow, int h, int wave, int cp) {
    constexpr bool FULL = (MODE == HM_SAMPLE || MODE == HM_FINAL);
    const int hoff = h * 64 + cp;
    if (NTOK == 64 || wave < NTOK / 8) {
#pragma unroll
        for (int j = 0; j < 8; ++j) { const size_t r = (size_t)(crow + 8 * wave + j);
            R.lf[j] = io.LOGF[r * 256 + hoff]; R.vv[j] = io.V[r * 256 + hoff]; R.qq[j] = FULL ? io.Q[r * 256 + hoff] : 0u; }
    } else {
#pragma unroll
        for (int j = 0; j < 8; ++j) { R.lf[j] = 0u; R.vv[j] = 0u; R.qq[j] = 0u; }
    }
}
template <int NTOK>
__device__ __forceinline__ void hg_epi(LAS unsigned char* lds, int par, const f32x4 (&acc)[4], int wave, int fr, int g4) {
    LAS float* SSQ = (LAS float*)(lds + H_SSQ); LAS bf16_t* YT = (LAS bf16_t*)(lds + H_YT); const LAS bf16_t* GT = (const LAS bf16_t*)(lds + H_GT);
    f32x4 a0[4], a1[4]; u32x2 sg[4];
    const f32x4 ghv = *(const LAS f32x4*)(lds + H_GHG + (16 * wave + 4 * g4) * 4);
#pragma unroll
    for (int ti = 0; ti < 4; ++ti) { const int t = 16 * ti + fr;
        a0[ti] = *(const LAS f32x4*)(SSQ + par * 512 + t * 8); a1[ti] = *(const LAS f32x4*)(SSQ + par * 512 + t * 8 + 4);
        sg[ti] = *(const LAS u32x2*)(GT + t * 136 + 16 * wave + 4 * g4); }
    __builtin_amdgcn_sched_barrier(0);
#pragma unroll
    for (int ti = 0; ti < 4; ++ti) { const int t = 16 * ti + fr;
        const float rs = __builtin_amdgcn_rsqf(((a0[ti][0] + a0[ti][1]) + (a0[ti][2] + a0[ti][3]) + (a1[ti][0] + a1[ti][1]) + (a1[ti][2] + a1[ti][3])) * (1.0f / 128.0f) + EPS);
        const float y0 = acc[ti][0] * rs * ghv[0] * bf_lo(sg[ti].x), y1 = acc[ti][1] * rs * ghv[1] * bf_hi(sg[ti].x);
        const float y2 = acc[ti][2] * rs * ghv[2] * bf_lo(sg[ti].y), y3 = acc[ti][3] * rs * ghv[3] * bf_hi(sg[ti].y);
        u32x2 w_; w_.x = cvt_pk_bf16(y0, y1); w_.y = cvt_pk_bf16(y2, y3);
        *(LAS u32x2*)(YT + t * 136 + 16 * wave + 4 * g4) = w_; }
}
template <int NTOK>
__device__ __forceinline__ void hg_flush(LAS unsigned char* lds, const HgrnIO& io, int crow, int h, int wave, int lane) {
    LAS bf16_t* YT = (LAS bf16_t*)(lds + H_YT);
#pragma unroll
    for (int p = 0; p < 2; ++p) { const int t = 8 * wave + 4 * p + (lane >> 4), ch = lane & 15;
        const u32x4 o = *(const LAS u32x4*)(YT + t * 136 + 8 * ch);
        if (NTOK == 64 || t < NTOK) *(u32x4*)(io.YCAT + (size_t)(crow + t) * DM + 512 + h * 128 + 8 * ch) = o; }
}
__device__ __forceinline__ void hg_prefix(LAS unsigned char* lds, const HRaw& R, int wave, int cp) {
    f32x2 t = unpk_f16(R.lf[0]);
#pragma unroll
    for (int j = 1; j < 8; ++j) t += unpk_f16(R.lf[j]);
    *(LAS f32x2*)((LAS float*)(lds + H_PART) + wave * 128 + 2 * cp) = t;
}
template <int MODE>
__device__ __forceinline__ void hg_estage(LAS unsigned char* lds, const HRaw& R, float (&ldacc)[2], int wave, int cp) {
    constexpr bool FULL = (MODE == HM_SAMPLE || MODE == HM_FINAL);
    LAS bf16_t* QT = (LAS bf16_t*)(lds + H_QT); LAS bf16_t* KT = (LAS bf16_t*)(lds + H_KT); LAS bf16_t* KD = (LAS bf16_t*)(lds + H_KD); LAS bf16_t* VT = (LAS bf16_t*)(lds + H_VT);
    LAS float* PART = (LAS float*)(lds + H_PART); LAS float* DEC = (LAS float*)(lds + H_DEC); LAS float* EBR = (LAS float*)(lds + H_EBR);
    f32x2 off = (f32x2){0.f, 0.f}, bref = off, blast = off, own = off;
#pragma unroll
    for (int w2 = 0; w2 < 8; ++w2) { const f32x2 t = *(const LAS f32x2*)(PART + w2 * 128 + 2 * cp); if (w2 < wave) off += t; if (w2 == wave) own = t; if (w2 < 4) bref += t; blast += t; }
    const f32x2 edl = (f32x2){fexp2(blast.x - bref.x), fexp2(blast.y - bref.y)};
    f32x2 fj[8]; float kt0[8], kt1[8];
    f32x2 r = (f32x2){fexp2(bref.x - off.x - own.x), fexp2(bref.y - off.y - own.y)};
#pragma unroll
    for (int j = 7; j >= 0; --j) { const f32x2 lfj = unpk_f16(R.lf[j]); fj[j] = (f32x2){fexp2(lfj.x), fexp2(lfj.y)};
        kt0[j] = (1.0f - fj[j].x) * r.x; kt1[j] = (1.0f - fj[j].y) * r.y;
        r *= fj[j]; }
    unsigned kd0[4], kd1[4], v0[4], v1[4];
    float kdp0 = 0.f, kdp1 = 0.f; unsigned vlo = 0u;
    f32x2 e = (f32x2){fexp2(off.x - bref.x), fexp2(off.y - bref.y)};
#pragma unroll
    for (int j = 0; j < 8; ++j) {
        const float k0 = kt0[j], k1 = kt1[j];
        const int t = 8 * wave + j;
        if (FULL) {
            e *= fj[j];
            *(LAS unsigned*)(QT + t * 136 + 2 * cp) = cvt_pk_bf16(bf_lo(R.qq[j]) * e.x, bf_hi(R.qq[j]) * e.y);
            *(LAS unsigned*)(KT + t * 136 + 2 * cp) = cvt_pk_bf16(k0, k1);
        }
        const float d0 = k0 * edl.x, d1 = k1 * edl.y;
        if (j & 1) { kd0[j >> 1] = cvt_pk_bf16(kdp0, d0); kd1[j >> 1] = cvt_pk_bf16(kdp1, d1); v0[j >> 1] = (vlo & 0xffffu) | (R.vv[j] << 16); v1[j >> 1] = (vlo >> 16) | (R.vv[j] & 0xffff0000u); }
        else { kdp0 = d0; kdp1 = d1; vlo = R.vv[j]; }
    }
    *(LAS u32x4*)(KD + (2 * cp) * 72 + 8 * wave) = (u32x4){kd0[0], kd0[1], kd0[2], kd0[3]};
    *(LAS u32x4*)(KD + (2 * cp + 1) * 72 + 8 * wave) = (u32x4){kd1[0], kd1[1], kd1[2], kd1[3]};
    *(LAS u32x4*)(VT + (2 * cp) * 72 + 8 * wave) = (u32x4){v0[0], v0[1], v0[2], v0[3]};
    *(LAS u32x4*)(VT + (2 * cp + 1) * 72 + 8 * wave) = (u32x4){v1[0], v1[1], v1[2], v1[3]};
    if (wave == 0) { *(LAS f32x2*)(DEC + 2 * cp) = (f32x2){fexp2(blast.x), fexp2(blast.y)}; if (FULL) *(LAS f32x2*)(EBR + 2 * cp) = (f32x2){fexp2(bref.x), fexp2(bref.y)}; ldacc[0] += blast.x; ldacc[1] += blast.y; }
}
template <int MODE>
__device__ __forceinline__ void hg_stepA(LAS unsigned char* lds, f32x4 (&S)[8], f32x4 (&accO)[4], bf16x8 (&vf)[2], int wave, int fr, int g4) {
    constexpr bool FULL = (MODE == HM_SAMPLE || MODE == HM_FINAL);
    LAS bf16_t* QT = (LAS bf16_t*)(lds + H_QT); LAS bf16_t* KT = (LAS bf16_t*)(lds + H_KT); LAS bf16_t* KD = (LAS bf16_t*)(lds + H_KD);
    LAS bf16_t* VT = (LAS bf16_t*)(lds + H_VT); LAS bf16_t* AM = (LAS bf16_t*)(lds + H_AM);
    LAS float* DEC = (LAS float*)(lds + H_DEC); LAS float* EBR = (LAS float*)(lds + H_EBR);
    if (FULL) {
#pragma unroll
        for (int rep = 0; rep < 2; ++rep) {
            const int idx = wave + 8 * rep;
            if (idx < 10) {
                const int ti = idx >= 6 ? 3 : (idx >= 3 ? 2 : (idx >= 1 ? 1 : 0)), sj = idx - ti * (ti + 1) / 2;
                f32x4 a4 = (f32x4){0.f, 0.f, 0.f, 0.f}, a5 = a4;
                bf16x8 af[4], bfr[4];
#pragma unroll
                for (int ks = 0; ks < 4; ++ks) { af[ks] = *(const LAS bf16x8*)(QT + (16 * ti + fr) * 136 + 32 * ks + 8 * g4); bfr[ks] = *(const LAS bf16x8*)(KT + (16 * sj + fr) * 136 + 32 * ks + 8 * g4); }
                __builtin_amdgcn_sched_barrier(0);
                a4 = __builtin_amdgcn_mfma_f32_16x16x32_bf16(af[0], bfr[0], a4, 0, 0, 0); a5 = __builtin_amdgcn_mfma_f32_16x16x32_bf16(af[1], bfr[1], a5, 0, 0, 0);
                a4 = __builtin_amdgcn_mfma_f32_16x16x32_bf16(af[2], bfr[2], a4, 0, 0, 0); a5 = __builtin_amdgcn_mfma_f32_16x16x32_bf16(af[3], bfr[3], a5, 0, 0, 0);
                a4 += a5;
                const int s = 16 * sj + fr;
#pragma unroll
                for (int r = 0; r < 4; ++r) { const int t = 16 * ti + 4 * g4 + r; const float v = (s <= t) ? a4[r] : 0.f; AM[t * 72 + s] = (bf16_t)(cvt_pk_bf16(v, 0.f) & 0xffffu); }
            }
        }
    }
#pragma unroll
    for (int ks = 0; ks < 2; ++ks) vf[ks] = *(const LAS bf16x8*)(VT + (16 * wave + fr) * 72 + 32 * ks + 8 * g4);
    f32x4 eb[4][2]; u32x2 qv[4][4][2];
    f32x4 dvv[4][2]; bf16x8 kf[4][2][2];
#define HG_LOADQ(ks) do { eb[ks][0] = *(const LAS f32x4*)(EBR + 32 * (ks) + 4 * g4); eb[ks][1] = *(const LAS f32x4*)(EBR + 32 * (ks) + 16 + 4 * g4); \
        _Pragma("unroll") for (int ti = 0; ti < 4; ++ti) { qv[ks][ti][0] = *(const LAS u32x2*)(QT + (16 * ti + fr) * 136 + 32 * (ks) + 4 * g4); qv[ks][ti][1] = *(const LAS u32x2*)(QT + (16 * ti + fr) * 136 + 32 * (ks) + 16 + 4 * g4); } } while (0)
#define HG_COMPQ(ks) do { const f32x4 s0 = S[2 * (ks)] * eb[ks][0], s1 = S[2 * (ks) + 1] * eb[ks][1]; \
        u32x4 sw; sw.x = cvt_pk_bf16(s0[0], s0[1]); sw.y = cvt_pk_bf16(s0[2], s0[3]); sw.z = cvt_pk_bf16(s1[0], s1[1]); sw.w = cvt_pk_bf16(s1[2], s1[3]); \
        const bf16x8 sa = __builtin_bit_cast(bf16x8, sw); \
        _Pragma("unroll") for (int ti = 0; ti < 4; ++ti) { const bf16x8 qf = __builtin_bit_cast(bf16x8, ((u32x4){qv[ks][ti][0].x, qv[ks][ti][0].y, qv[ks][ti][1].x, qv[ks][ti][1].y})); \
            accO[ti] = __builtin_amdgcn_mfma_f32_16x16x32_bf16(sa, qf, accO[ti], 0, 0, 0); } } while (0)
#define HG_LOADK(g) do { _Pragma("unroll") for (int q = 0; q < 2; ++q) { dvv[g][q] = *(const LAS f32x4*)(DEC + 16 * (2 * (g) + q) + 4 * g4); \
        _Pragma("unroll") for (int ks = 0; ks < 2; ++ks) kf[g][q][ks] = *(const LAS bf16x8*)(KD + (16 * (2 * (g) + q) + fr) * 72 + 32 * ks + 8 * g4); } } while (0)
#define HG_COMPK(g) do { _Pragma("unroll") for (int q = 0; q < 2; ++q) { S[2 * (g) + q] = S[2 * (g) + q] * dvv[g][q]; \
        _Pragma("unroll") for (int ks = 0; ks < 2; ++ks) S[2 * (g) + q] = __builtin_amdgcn_mfma_f32_16x16x32_bf16(kf[g][q][ks], vf[ks], S[2 * (g) + q], 0, 0, 0); } } while (0)
#define HG_SB() __builtin_amdgcn_sched_barrier(0)
    if (FULL) {
#pragma unroll
        for (int ti = 0; ti < 4; ++ti) accO[ti] = (f32x4){0.f, 0.f, 0.f, 0.f};
        HG_LOADQ(0); HG_LOADQ(1); HG_SB();
        HG_COMPQ(0); HG_SB(); HG_LOADQ(2); HG_SB();
        HG_COMPQ(1); HG_SB(); HG_LOADQ(3); HG_SB();
        HG_COMPQ(2); HG_SB(); HG_LOADK(0); HG_SB();
        HG_COMPQ(3); HG_SB(); HG_LOADK(1); HG_SB();
    } else { HG_LOADK(0); HG_LOADK(1); HG_SB(); }
    HG_COMPK(0); HG_SB(); HG_LOADK(2); HG_SB();
    HG_COMPK(1); HG_SB(); HG_LOADK(3); HG_SB();
    HG_COMPK(2); HG_COMPK(3);
#undef HG_LOADQ
#undef HG_COMPQ
#undef HG_LOADK
#undef HG_COMPK
#undef HG_SB
}
__device__ __forceinline__ void hg_stepB(LAS unsigned char* lds, f32x4 (&accO)[4], const bf16x8 (&vf)[2], int par, int wave, int fr, int g4) {
    LAS bf16_t* AM = (LAS bf16_t*)(lds + H_AM); LAS float* SSQ = (LAS float*)(lds + H_SSQ);
    bf16x8 bfr[4][2];
#pragma unroll
    for (int ti = 0; ti < 4; ++ti)
#pragma unroll
        for (int ks = 0; ks < 2; ++ks) { if (ks == 1 && ti < 2) continue; bfr[ti][ks] = *(const LAS bf16x8*)(AM + (16 * ti + fr) * 72 + 32 * ks + 8 * g4); }
    __builtin_amdgcn_sched_barrier(0);
#pragma unroll
    for (int ks = 0; ks < 2; ++ks)
#pragma unroll
        for (int ti = 0; ti < 4; ++ti) { if (ks == 1 && ti < 2) continue; accO[ti] = __builtin_amdgcn_mfma_f32_16x16x32_bf16(vf[ks], bfr[ti][ks], accO[ti], 0, 0, 0); }
    float pz[4];
#pragma unroll
    for (int ti = 0; ti < 4; ++ti) pz[ti] = (accO[ti][0] * accO[ti][0] + accO[ti][1] * accO[ti][1]) + (accO[ti][2] * accO[ti][2] + accO[ti][3] * accO[ti][3]);
    const bool hi2 = (g4 & 2) != 0, hi1 = (g4 & 1) != 0;
    const float k0 = hi2 ? pz[2] : pz[0], k1 = hi2 ? pz[3] : pz[1], s0 = hi2 ? pz[0] : pz[2], s1 = hi2 ? pz[1] : pz[3];
    const float r0 = __shfl_xor(s0, 32), r1 = __shfl_xor(s1, 32);
    const float u0 = k0 + r0, u1 = k1 + r1;
    const float keep = hi1 ? u1 : u0, send = hi1 ? u0 : u1;
    const float tot = keep + __shfl_xor(send, 16);
    SSQ[par * 512 + (16 * g4 + fr) * 8 + wave] = tot;
}
template <int NTOK>
__device__ __forceinline__ void hg_gates_load(u32x4 (&gr)[2], const HgrnIO& io, int crow, int h, int wave, int lane) {
#pragma unroll
    for (int p = 0; p < 2; ++p) { const int t = 8 * wave + 4 * p + (lane >> 4), ch = lane & 15;
        gr[p] = (NTOK == 64 || t < NTOK) ? *(const u32x4*)(io.SG + (size_t)(crow + t) * 256 + h * 64 + 4 * ch) : (u32x4){0u, 0u, 0u, 0u}; }
}
__device__ __forceinline__ void hg_gates_put(LAS unsigned char* lds, const u32x4 (&gr)[2], int wave, int lane) {
#pragma unroll
    for (int p = 0; p < 2; ++p) { const int t = 8 * wave + 4 * p + (lane >> 4), ch = lane & 15; *(LAS u32x4*)((LAS bf16_t*)(lds + H_GT) + t * 136 + 8 * ch) = gr[p]; }
}
template <int MODE, int NTOK>
__device__ __forceinline__ void hg_step(LAS unsigned char* lds, const HgrnIO& io, HRaw& Rn, int c, int nch, int row0, int h, f32x4 (&S)[8], float (&ldacc)[2],
                                        f32x4 (&accP)[4], int wave, int lane) {
    constexpr bool FULL = (MODE == HM_SAMPLE || MODE == HM_FINAL);
    const int cp = lane, fr = lane & 15, g4 = lane >> 4, crow = row0 + 64 * c, par = c & 1;
    const bool more = c + 1 < nch;
    bf16x8 vf[2]; u32x4 gr[2];
    if (FULL) {
        if (c > 0) hg_epi<NTOK>(lds, par ^ 1, accP, wave, fr, g4);
        hg_gates_load<NTOK>(gr, io, crow, h, wave, lane);
    }
    hg_stepA<MODE>(lds, S, accP, vf, wave, fr, g4);
    if (more) hg_prefix(lds, Rn, wave, cp);
    LDS_BAR();
    if (FULL) { if (c > 0) hg_flush<NTOK>(lds, io, crow - 64, h, wave, lane); hg_stepB(lds, accP, vf, par, wave, fr, g4); hg_gates_put(lds, gr, wave, lane); }
    if (more) {
        hg_estage<MODE>(lds, Rn, ldacc, wave, cp);
        if (c + 3 < nch) hg_load<MODE, NTOK>(Rn, io, crow + 192, h, wave, cp);
    }
    LDS_BAR();
}
template <int MODE, int NTOK>
__device__ __forceinline__ void hgrn_chunks(LAS unsigned char* lds, const HgrnIO& io, int row0, int nch, int h, f32x4 (&S)[8], float (&ldacc)[2], int tid, int wave, int lane) {
    constexpr bool FULL = (MODE == HM_SAMPLE || MODE == HM_FINAL);
    const int fr = lane & 15, g4 = lane >> 4;
    if (FULL) {
        if (tid < 128) ((LAS float*)(lds + H_GHG))[tid] = io.ghg[tid];
        for (int i = tid; i < 9216 / 4; i += 512) ((LAS unsigned*)(lds + H_AM))[i] = 0u;
    }
    HRaw RA, RB;
    hg_load<MODE, NTOK>(RA, io, row0, h, wave, lane);
    if (nch > 1) hg_load<MODE, NTOK>(RB, io, row0 + 64, h, wave, lane);
    f32x4 accP[4];
#pragma unroll
    for (int ti = 0; ti < 4; ++ti) accP[ti] = (f32x4){0.f, 0.f, 0.f, 0.f};
    { hg_prefix(lds, RA, wave, lane); LDS_BAR(); hg_estage<MODE>(lds, RA, ldacc, wave, lane); if (nch > 2) hg_load<MODE, NTOK>(RA, io, row0 + 128, h, wave, lane); LDS_BAR(); }
    for (int c = 0; c < nch; c += 2) {
        hg_step<MODE, NTOK>(lds, io, RB, c, nch, row0, h, S, ldacc, accP, wave, lane);
        if (c + 1 < nch) hg_step<MODE, NTOK>(lds, io, RA, c + 1, nch, row0, h, S, ldacc, accP, wave, lane);
    }
    if (FULL) { hg_epi<NTOK>(lds, (nch - 1) & 1, accP, wave, fr, g4); LDS_BAR(); hg_flush<NTOK>(lds, io, row0 + 64 * (nch - 1), h, wave, lane); }
    LDS_BAR();
}

constexpr int L_KD = 0;
constexpr int L_VT = 34816;
static_assert(L_VT + 34816 <= H_PART, "local128 lds");
struct HRawL { unsigned lf[16], vv[16]; };
__device__ __forceinline__ void hl_load(HRawL& R, const HgrnIO& io, int crow, int h, int wave, int cp) {
    const int hoff = h * 64 + cp;
#pragma unroll
    for (int j = 0; j < 16; ++j) { const size_t r = (size_t)(crow + 16 * wave + j); R.lf[j] = io.LOGF[r * 256 + hoff]; R.vv[j] = io.V[r * 256 + hoff]; }
}
__device__ __forceinline__ void hl_prefix(LAS unsigned char* lds, const HRawL& R, int wave, int cp) {
    f32x2 t = unpk_f16(R.lf[0]);
#pragma unroll
    for (int j = 1; j < 16; ++j) t += unpk_f16(R.lf[j]);
    *(LAS f32x2*)((LAS float*)(lds + H_PART) + wave * 128 + 2 * cp) = t;
}
__device__ __forceinline__ void hl_estage(LAS unsigned char* lds, const HRawL& R, float (&ldacc)[2], int wave, int cp) {
    LAS bf16_t* KD = (LAS bf16_t*)(lds + L_KD); LAS bf16_t* VT = (LAS bf16_t*)(lds + L_VT);
    LAS float* PART = (LAS float*)(lds + H_PART); LAS float* DEC = (LAS float*)(lds + H_DEC);
    f32x2 off = (f32x2){0.f, 0.f}, blast = off, own = off;
#pragma unroll
    for (int w2 = 0; w2 < 8; ++w2) { const f32x2 t = *(const LAS f32x2*)(PART + w2 * 128 + 2 * cp); if (w2 < wave) off += t; if (w2 == wave) own = t; blast += t; }
    unsigned kd0[8], kd1[8], v0[8], v1[8];
    float kp0 = 0.f, kp1 = 0.f; unsigned vhi = 0u;
    f32x2 r = (f32x2){fexp2(blast.x - off.x - own.x), fexp2(blast.y - off.y - own.y)};
#pragma unroll
    for (int j = 15; j >= 0; --j) {
        const f32x2 lfj = unpk_f16(R.lf[j]); const f32x2 f = (f32x2){fexp2(lfj.x), fexp2(lfj.y)};
        const float d0 = (1.0f - f.x) * r.x, d1 = (1.0f - f.y) * r.y;
        r *= f;
        if (j & 1) { kp0 = d0; kp1 = d1; vhi = R.vv[j]; }
        else { kd0[j >> 1] = cvt_pk_bf16(d0, kp0); kd1[j >> 1] = cvt_pk_bf16(d1, kp1); v0[j >> 1] = (R.vv[j] & 0xffffu) | (vhi << 16); v1[j >> 1] = (R.vv[j] >> 16) | (vhi & 0xffff0000u); }
    }
#pragma unroll
    for (int q = 0; q < 2; ++q) {
        *(LAS u32x4*)(KD + (2 * cp) * 136 + 16 * wave + 8 * q) = (u32x4){kd0[4 * q], kd0[4 * q + 1], kd0[4 * q + 2], kd0[4 * q + 3]};
        *(LAS u32x4*)(KD + (2 * cp + 1) * 136 + 16 * wave + 8 * q) = (u32x4){kd1[4 * q], kd1[4 * q + 1], kd1[4 * q + 2], kd1[4 * q + 3]};
        *(LAS u32x4*)(VT + (2 * cp) * 136 + 16 * wave + 8 * q) = (u32x4){v0[4 * q], v0[4 * q + 1], v0[4 * q + 2], v0[4 * q + 3]};
        *(LAS u32x4*)(VT + (2 * cp + 1) * 136 + 16 * wave + 8 * q) = (u32x4){v1[4 * q], v1[4 * q + 1], v1[4 * q + 2], v1[4 * q + 3]};
    }
    if (wave == 0) { *(LAS f32x2*)(DEC + 2 * cp) = (f32x2){fexp2(blast.x), fexp2(blast.y)}; ldacc[0] += blast.x; ldacc[1] += blast.y; }
}
__device__ __forceinline__ void hl_step3(LAS unsigned char* lds, f32x4 (&S)[8], int wave, int fr, int g4) {
    LAS bf16_t* KD = (LAS bf16_t*)(lds + L_KD); LAS bf16_t* VT = (LAS bf16_t*)(lds + L_VT); LAS float* DEC = (LAS float*)(lds + H_DEC);
    bf16x8 vf[4];
#pragma unroll
    for (int ks = 0; ks < 4; ++ks) vf[ks] = *(const LAS bf16x8*)(VT + (16 * wave + fr) * 136 + 32 * ks + 8 * g4);
#pragma unroll
    for (int kt = 0; kt < 8; ++kt) {
        const f32x4 dv = *(const LAS f32x4*)(DEC + 16 * kt + 4 * g4);
        S[kt] = S[kt] * dv;
#pragma unroll
        for (int ks = 0; ks < 4; ++ks) {
            const bf16x8 af = *(const LAS bf16x8*)(KD + (16 * kt + fr) * 136 + 32 * ks + 8 * g4);
            S[kt] = __builtin_amdgcn_mfma_f32_16x16x32_bf16(af, vf[ks], S[kt], 0, 0, 0);
        }
    }
}
__device__ __forceinline__ void hl_step(LAS unsigned char* lds, const HgrnIO& io, HRawL& Rn, int c, int nch, int row0, int h, f32x4 (&S)[8], float (&ldacc)[2], int wave, int lane) {
    const bool more = c + 1 < nch;
    hl_step3(lds, S, wave, lane & 15, lane >> 4);
    if (more) hl_prefix(lds, Rn, wave, lane);
    LDS_BAR();
    if (more) { hl_estage(lds, Rn, ldacc, wave, lane); if (c + 3 < nch) hl_load(Rn, io, row0 + 128 * (c + 3), h, wave, lane); }
    LDS_BAR();
}
__device__ __forceinline__ void hgrn_local128(LAS unsigned char* lds, const HgrnIO& io, int row0, int nch, int h, f32x4 (&S)[8], float (&ldacc)[2], int wave, int lane) {
    HRawL RA, RB;
    hl_load(RA, io, row0, h, wave, lane);
    hl_load(RB, io, row0 + 128, h, wave, lane);
    { hl_prefix(lds, RA, wave, lane); LDS_BAR(); hl_estage(lds, RA, ldacc, wave, lane); hl_load(RA, io, row0 + 256, h, wave, lane); LDS_BAR(); }
    for (int c = 0; c < nch; c += 2) {
        hl_step(lds, io, RB, c, nch, row0, h, S, ldacc, wave, lane);
        hl_step(lds, io, RA, c + 1, nch, row0, h, S, ldacc, wave, lane);
    }
    LDS_BAR();
}

__device__ __forceinline__ void state_load(const float* src, f32x4 (&S)[8], int wave, int lane) {
    const int fr = lane & 15, g4 = lane >> 4;
#pragma unroll
    for (int kt = 0; kt < 8; ++kt)
#pragma unroll
        for (int r = 0; r < 4; ++r) S[kt][r] = src[(16 * kt + 4 * g4 + r) * 128 + 16 * wave + fr];
}
__device__ __forceinline__ void state_store(float* dst, const f32x4 (&S)[8], int wave, int lane) {
    const int fr = lane & 15, g4 = lane >> 4;
#pragma unroll
    for (int kt = 0; kt < 8; ++kt)
#pragma unroll
        for (int r = 0; r < 4; ++r) dst[(16 * kt + 4 * g4 + r) * 128 + 16 * wave + fr] = S[kt][r];
}

constexpr int PL_WP = 0;
constexpr int PL_DT = 34816;
constexpr int PL_END = PL_DT + 256 * 272;
static_assert(PL_END <= 131072, "pool lds");
constexpr int CW_POOL = 64;
template <int W>
__device__ __forceinline__ void pool_dtile(LAS bf16_t* DT, const unsigned* U, const float* cache, float* outp, int m0, int g, int team, int wave, int lane) {
    const int cp = lane, mrow = m0 + 32 * wave;
    const bool is_s = mrow >= MP / 2;
    int pos0, seqrow0, sb = 0, bb = 0;
    if (!is_s) { pos0 = mrow & (SEQ - 1); seqrow0 = mrow - pos0; bb = team * 4 + (mrow >> 13); } else { sb = (mrow - MP / 2) >> 5; pos0 = 0; seqrow0 = mrow; }
    const int ucol = g * 64 + cp;
    f32x2 uv[47];
#pragma unroll
    for (int i = 16 - W; i < 15; ++i) {
        const int pos = pos0 - 15 + i, pc = pos < 0 ? 0 : pos;
        int ci = 15 + pos; ci = ci < 0 ? 0 : (ci > 14 ? 14 : ci);
        const unsigned w = U[(size_t)(seqrow0 + pc) * 256 + ucol];
        const f32x2 cv = *(const f32x2*)(cache + (size_t)(sb * 15 + ci) * 512 + 2 * ucol);
        f32x2 r = (f32x2){bf_lo(w), bf_hi(w)};
        if (pos < 0) r = is_s ? cv : (f32x2){0.f, 0.f};
        uv[i] = r;
    }
#pragma unroll
    for (int i = 15; i < 47; ++i) { const unsigned w = U[(size_t)(seqrow0 + pos0 + i - 15) * 256 + ucol]; uv[i] = (f32x2){bf_lo(w), bf_hi(w)}; }
    f32x2 sum = (f32x2){0.f, 0.f};
#pragma unroll
    for (int i = 16 - W; i < 15; ++i) sum += uv[i];
#pragma unroll
    for (int t = 0; t < 32; ++t) {
        const int pos = pos0 + t;
        const f32x2 u = uv[15 + t];
        sum += u;
        const int cnt = is_s ? W : (pos + 1 < W ? pos + 1 : W);
        const float ic = 1.0f / (float)cnt;
        const f32x2 d = sum * ic - u;
        sum -= uv[15 + t - W + 1];
        *(LAS unsigned*)(DT + (32 * wave + t) * 136 + 2 * cp) = cvt_pk_bf16(d.x, d.y);
        if (!is_s && pos >= SEQ - 15) *(f32x2*)(outp + OFF_PP + (size_t)(bb * 15 + pos - (SEQ - 15)) * 512 + 2 * ucol) = u;
        if (is_s && pos >= DSEQ - 15) *(f32x2*)(outp + OFF_PS + (size_t)(sb * 15 + pos - (DSEQ - 15)) * 512 + 2 * ucol) = u;
    }
}
__device__ __forceinline__ void pool_phase(LAS unsigned char* lds, ArgP ap, volatile LAS unsigned* MISC, int team, int tl, int tid, int wave, int lane) {
    unsigned char* ws = ap->ws; float* outp = ap->out;
    unsigned char* tws = ws + WS_TEAM + (size_t)team * TEAM_BYTES;
    const unsigned* U = (const unsigned*)(tws + T_U);
    const bf16_t* WPT = (const bf16_t*)(ws + WS_WP);
    bf16_t* YCAT = (bf16_t*)(tws + T_A);
    unsigned* ctl = (unsigned*)(ws + WS_CTL);
    const float* cache = ap->in[I_CACHE];
    LAS bf16_t* WP = (LAS bf16_t*)(lds + PL_WP); LAS bf16_t* DT = (LAS bf16_t*)(lds + PL_DT);
    const int fr = lane & 15, g4 = lane >> 4;
    int g = tl & 3, loaded = -1, tries = 0, slot = 0;
    while (tries < 4) {
        if (tid == 0) MISC[4 + slot] = __hip_atomic_fetch_add(ctl + CW_POOL * (1 + 4 * team + g), 1u, __ATOMIC_RELAXED, __HIP_MEMORY_SCOPE_AGENT);
        __syncthreads();
        const int it = (int)MISC[4 + slot]; slot ^= 1;
        if (it >= 128 + nsp_of(team)) { g = (g + 1) & 3; ++tries; continue; }
        if (loaded != g) {
            for (int i = tid; i < 128 * 16; i += 512) { const int r = i >> 4, c = i & 15; *(LAS u32x4*)(WP + r * 136 + 8 * c) = *(const u32x4*)(WPT + (size_t)g * 16384 + r * 128 + 8 * c); }
            loaded = g;
            __syncthreads();
        }
        const int m0 = it * 256;
        switch (g) {
            case 0: pool_dtile<2>(DT, U, cache, outp, m0, g, team, wave, lane); break;
            case 1: pool_dtile<4>(DT, U, cache, outp, m0, g, team, wave, lane); break;
            case 2: pool_dtile<8>(DT, U, cache, outp, m0, g, team, wave, lane); break;
            default: pool_dtile<16>(DT, U, cache, outp, m0, g, team, wave, lane); break;
        }
        asm volatile("s_waitcnt lgkmcnt(0)" ::: "memory");
        bf16x8 bfr[2][4];
#pragma unroll
        for (int tt = 0; tt < 2; ++tt)
#pragma unroll
            for (int ks = 0; ks < 4; ++ks) bfr[tt][ks] = *(const LAS bf16x8*)(DT + (32 * wave + 16 * tt + fr) * 136 + 32 * ks + 8 * g4);
        const float* psc = ap->in[I_PSCALE] + g * 128;
#pragma unroll 2
        for (int nb = 0; nb < 8; ++nb) {
            bf16x8 af[4];
#pragma unroll
            for (int ks = 0; ks < 4; ++ks) af[ks] = *(const LAS bf16x8*)(WP + (16 * nb + fr) * 136 + 32 * ks + 8 * g4);
            const f32x4 sc = *(const f32x4*)(psc + 16 * nb + 4 * g4);
#pragma unroll
            for (int tt = 0; tt < 2; ++tt) {
                f32x4 acc = (f32x4){0.f, 0.f, 0.f, 0.f};
#pragma unroll
                for (int ks = 0; ks < 4; ++ks) acc = __builtin_amdgcn_mfma_f32_16x16x32_bf16(af[ks], bfr[tt][ks], acc, 0, 0, 0);
                acc = acc * sc;
                u32x2 w; w.x = cvt_pk_bf16(acc[0], acc[1]); w.y = cvt_pk_bf16(acc[2], acc[3]);
                *(LAS u32x2*)(DT + (32 * wave + 16 * tt + fr) * 136 + 16 * nb + 4 * g4) = w;
            }
        }
        asm volatile("" ::: "memory");
#pragma unroll
        for (int p = 0; p < 8; ++p) { const int row = 32 * wave + 4 * p + (lane >> 4), ch = lane & 15;
            const u32x4 o = *(const LAS u32x4*)(DT + row * 136 + 8 * ch);
            *(u32x4*)(YCAT + (size_t)(m0 + row) * DM + g * 128 + 8 * ch) = o; }
        asm volatile("" ::: "memory");
    }
    __syncthreads();
}

constexpr int CW_BAR = 1024;
#define XB_TMO      128
#define XB_XCNT(j)  (256  + 64 * (j))
#define XB_XSUB(j)  (1280 + 64 * (j))
#define XB_XGEN(j)  (2304 + 64 * (j))
#define XB_TOP      3328
#define XB_TOPGEN   3392
#define XCD_BAR_WORDS 3456
#define XB_SPIN_CAP (1u << 20)
constexpr unsigned TEAM_WGS = 128;
__device__ __forceinline__ unsigned xb_ld(unsigned* p)              { return __hip_atomic_load(p, __ATOMIC_RELAXED, __HIP_MEMORY_SCOPE_AGENT); }
__device__ __forceinline__ unsigned xb_add(unsigned* p, unsigned v) { return __hip_atomic_fetch_add(p, v, __ATOMIC_RELAXED, __HIP_MEMORY_SCOPE_AGENT); }
__device__ __forceinline__ unsigned xb_xcc_id() { return (unsigned)__builtin_amdgcn_s_getreg((3 << 11) | 20) & 0xFu; }
#define XB_SPIN(cond, bar) do { unsigned _sp = 0; while (cond) { __builtin_amdgcn_s_sleep(1); \
    if ((++_sp & 255u) == 0u) { if (xb_ld(&(bar)[XB_TMO])) break; if (_sp > XB_SPIN_CAP) { atomicAdd(&(bar)[XB_TMO], 1u); break; } } } } while (0)
struct XcdBarrier { unsigned* bar; unsigned x; volatile LAS unsigned* st; unsigned G; };
__device__ __forceinline__ XcdBarrier xcd_barrier_post(unsigned* bar, volatile LAS unsigned* st, unsigned G) {
    XcdBarrier b; b.bar = bar; b.x = xb_xcc_id(); b.st = st; b.G = G;
    if (threadIdx.x == 0) (void)xb_add(&bar[XB_XCNT(b.x)], 1u);
    return b;
}
__device__ __forceinline__ void xcd_barrier_complete(unsigned* bar, unsigned x, unsigned G, unsigned& nloc, unsigned& nx) {
    unsigned sum, cnt, mine, sp = 0u;
    for (;;) {
        sum = 0u; cnt = 0u; mine = 0u;
#pragma unroll
        for (unsigned j = 0; j < 16; ++j) { const unsigned c = xb_ld(&bar[XB_XCNT(j)]); sum += c; cnt += (c > 0u) ? 1u : 0u; mine = (j == x) ? c : mine; }
        if (sum == G) break;
        __builtin_amdgcn_s_sleep(1);
        if ((++sp & 255u) == 0u) { if (xb_ld(&bar[XB_TMO])) break; if (sp > XB_SPIN_CAP) { atomicAdd(&bar[XB_TMO], 1u); break; } }
    }
    nloc = mine > 0u ? mine : 1u; nx = cnt > 0u ? cnt : 1u;
}
__device__ __forceinline__ void xcd_barrier(const XcdBarrier& b) {
    asm volatile("s_waitcnt vmcnt(0)" ::: "memory");
    __syncthreads();
    if (threadIdx.x == 0) {
        unsigned* bar = b.bar;
        __builtin_amdgcn_s_waitcnt(0);
        unsigned nloc = b.st[0], nx = b.st[1];
        if (nloc == 0u) { xcd_barrier_complete(bar, b.x, b.G, nloc, nx); b.st[0] = nloc; b.st[1] = nx; }
        const unsigned old = xb_add(&bar[XB_XSUB(b.x)], 1u);
        const unsigned gen = old / nloc;
        if (old + 1u == (gen + 1u) * nloc) {
            __builtin_amdgcn_fence(__ATOMIC_RELEASE, "agent");
            asm volatile("s_waitcnt vmcnt(0)" ::: "memory");
            const unsigned og = xb_add(&bar[XB_TOP], 1u);
            const unsigned tg = og / nx;
            if (og + 1u == (tg + 1u) * nx) xb_add(&bar[XB_TOPGEN], 1u);
            else XB_SPIN(xb_ld(&bar[XB_TOPGEN]) == tg, bar);
            __builtin_amdgcn_fence(__ATOMIC_ACQUIRE, "agent");
            xb_add(&bar[XB_XGEN(b.x)], 1u);
            asm volatile("s_waitcnt vmcnt(0)" ::: "memory");
        } else {
            XB_SPIN(xb_ld(&bar[XB_XGEN(b.x)]) == gen, bar);
            __builtin_amdgcn_fence(__ATOMIC_ACQUIRE, "agent");
            asm volatile("s_waitcnt vmcnt(0)" ::: "memory");
        }
    }
    __syncthreads();
}
constexpr int MISC_OFF = 131072;

constexpr int CW_ROWQ = 12288, CW_FLAG = 12288 + 512, CW_WFLAG = CW_FLAG + 128;
constexpr int P1_TAIL_UNITS = (128 + 2) * (DIN / 256) - 10 * 128;
static_assert(P1_TAIL_UNITS == 20 && CW_WFLAG * 4 + 4 <= (int)CTL_ZERO_BYTES, "P1 tail");
#define ROWQ_BEGIN(qw) { int _slot = 0; unsigned _nxt = 0u; if (tid == 0) MISC[10] = __hip_atomic_fetch_add((qw), 1u, __ATOMIC_RELAXED, __HIP_MEMORY_SCOPE_AGENT); LDS_BAR(); int _blk = (int)MISC[10]; \
    while (_blk < (MP / 2) / 32) { if (tid == 0) _nxt = __hip_atomic_fetch_add((qw), 1u, __ATOMIC_RELAXED, __HIP_MEMORY_SCOPE_AGENT); const int r0 = _blk * 32 + wave * RW;
#define ROWQ_END() _slot ^= 1; if (tid == 0) MISC[10 + _slot] = _nxt; LDS_BAR(); _blk = (int)MISC[10 + _slot]; } }
__device__ __forceinline__ void p5b_rows(unsigned char* twb, int tt, int r0, float* outp, const f32x4 (&g3)[4], int lane) {
    const bf16_t* FB = (const bf16_t*)(twb + T_C); const bf16_t* X1 = (const bf16_t*)(twb + T_X1); const float* SS = (const float*)(twb + T_SS); const float* RS2 = (const float*)(twb + T_RS2);
    u32x2 xv[RW][4], y[RW][4]; float ssp[RW], r2v[RW];
    { const f32x4 sv = *(const f32x4*)(SS + (size_t)(r0 >> 4) * 256 + (lane & 15) * 16 + (r0 & 15)); ssp[0] = sv[0]; ssp[1] = sv[1]; ssp[2] = sv[2]; ssp[3] = sv[3]; }
#pragma unroll
    for (int i = 0; i < RW; ++i) { const int r = r0 + i; const u32x2* xr = (const u32x2*)(X1 + (size_t)r * DM) + lane; const u32x2* fr_ = (const u32x2*)(FB + (size_t)r * DM) + lane;
        r2v[i] = RS2[r];
#pragma unroll
        for (int j = 0; j < 4; ++j) { xv[i][j] = xr[64 * j]; y[i][j] = fr_[64 * j]; } }
#pragma unroll
    for (int i = 0; i < RW; ++i) { const int r = r0 + i;
        const float rs3 = 1.0f / sqrtf(sum16(ssp[i]) * (1.0f / DM) + EPS), ir2 = 1.0f / r2v[i];
        f32x4* orow = (f32x4*)(outp + OFF_Y + (size_t)team_row(tt, r) * DM) + lane;
#pragma unroll
        for (int j = 0; j < 4; ++j) { const u32x2 xx = xv[i][j], yy = y[i][j]; f32x4 x;
            x.x = bf_lo(xx.x) * ir2 + bf_lo(yy.x) * rs3 * g3[j].x; x.y = bf_hi(xx.x) * ir2 + bf_hi(yy.x) * rs3 * g3[j].y; x.z = bf_lo(xx.y) * ir2 + bf_lo(yy.y) * rs3 * g3[j].z; x.w = bf_hi(xx.y) * ir2 + bf_hi(yy.y) * rs3 * g3[j].w;
            orow[64 * j] = x; } }
}
#define PHASE_BEGIN() ArgP ap = get_args(); unsigned char* ws = ap->ws; unsigned char* tws = ws + WS_TEAM + (size_t)team * TEAM_BYTES; const int tid = opaque_tid(), lane = tid & 63, wave = __builtin_amdgcn_readfirstlane(tid >> 6); (void)lane; (void)wave; (void)ws; (void)tws
__global__ void __launch_bounds__(512, 2) fwd_megakernel(Args a_unused) {
    extern __shared__ __attribute__((aligned(16))) unsigned char lds_raw[];
    LAS unsigned char* lds = (LAS unsigned char*)lds_raw;
    cg::grid_group grid = cg::this_grid();
    const int bid = blockIdx.x;
    const int team = (bid & 7) >> 2, tl = ((bid >> 3) << 2) | (bid & 3);
    constexpr int G = 128;
    volatile LAS unsigned* MISC = (volatile LAS unsigned*)(lds + MISC_OFF);
    if (threadIdx.x < 16) MISC[threadIdx.x] = 0u;
    __syncthreads();
    const XcdBarrier bar = xcd_barrier_post((unsigned*)(get_args()->ws + WS_CTL) + CW_BAR + team * XCD_BAR_WORDS, MISC, TEAM_WGS);
    const XcdBarrier gbar = xcd_barrier_post((unsigned*)(get_args()->ws + WS_CTL) + CW_BAR + 2 * XCD_BAR_WORDS, MISC + 2, 256u);
#define TEAM_BAR() xcd_barrier(bar)

    { PHASE_BEGIN(); p0_weights<0>(ap, lds, tid, wave, lane, bid * 8 + wave, gridDim.x * 8); p0_xn(ap, 0, bid * 8 + wave, gridDim.x * 8, lane); }
    if (get_args()->ws == nullptr) grid.sync();
    xcd_barrier(gbar);
    if (team == 1) { { PHASE_BEGIN(); p0_xn(ap, 1, tl * 8 + wave, G * 8, lane); } TEAM_BAR(); }

    {
        PHASE_BEGIN();
        pg8::Gemm g{(const bf16_t*)(tws + T_XB), (const bf16_t*)(ws + WS_WIN), TROWS, DIN, DM}; pg8::StaticOrder S; S.init(128 + nsp_of(team), DIN, DM, G, tl, 0);
        pg8::EpiZ E{tws, (const float*)(ws + WS_LB), lds + pg8::EPI_STG_OFF};
        pg8::gemm_phase<pg8::EpiZ, pg8::StaticOrder, true, true>(lds, g, S, E);
        if (team == 0 && tl >= P1_TAIL_UNITS) p0_weights<1>(ap, lds, tid, wave, lane, (tl - P1_TAIL_UNITS) * 8 + wave, (G - P1_TAIL_UNITS) * 8);
    }
    TEAM_BAR();
    if (team == 0 && tl == 0 && threadIdx.x == 0) __hip_atomic_store((unsigned*)(get_args()->ws + WS_CTL) + CW_WFLAG, 1u, __ATOMIC_RELEASE, __HIP_MEMORY_SCOPE_AGENT);

    const int seq = team * 16 + (tl >> 3), seg = tl & 7;
    {
        PHASE_BEGIN();
        HgrnIO io{(const unsigned*)(tws + T_Q), (const unsigned*)(tws + T_V), (const unsigned*)(tws + T_SG), (const unsigned*)(tws + T_LOGF), (bf16_t*)(tws + T_A), ap->in[I_GHG]};
        if (seg < 7) {
            f32x4 S[8]; float ldacc[2] = {0.f, 0.f};
#pragma unroll
            for (int kt = 0; kt < 8; ++kt) S[kt] = (f32x4){0.f, 0.f, 0.f, 0.f};
            hgrn_local128(lds, io, ((seq >> 2) & 3) * SEQ + seg * 1024, 8, seq & 3, S, ldacc, wave, lane);
            float* sl = (float*)(ws + WS_SLOC) + (size_t)(seq * 8 + seg) * 16384;
#pragma unroll
            for (int kt = 0; kt < 8; ++kt)
#pragma unroll
                for (int r = 0; r < 4; ++r) sl[((wave * 8 + kt) * 4 + r) * 64 + lane] = S[kt][r];
            if (wave == 0) *(f32x2*)((float*)(ws + WS_LD) + (seq * 8 + seg) * 128 + 2 * lane) = (f32x2){ldacc[0], ldacc[1]};
        } else {
            if (team == 0)
            for (int i = 0; i < 4; ++i) {
                const int idx = (tl >> 3) * 4 + i, sb = idx >> 2, h = idx & 3;
                f32x4 S[8]; float ldacc[2] = {0.f, 0.f};
                state_load(ap->in[I_STATE] + (size_t)idx * 16384, S, wave, lane);
                hgrn_chunks<HM_SAMPLE, 32>(lds, io, MP / 2 + sb * DSEQ, 1, h, S, ldacc, tid, wave, lane);
                state_store(ap->out + OFF_HS + (size_t)idx * 16384, S, wave, lane);
            }
        }
        pool_phase(lds, ap, MISC, team, tl, tid, wave, lane);
    }
    TEAM_BAR();

    {
        PHASE_BEGIN();
        HgrnIO io{(const unsigned*)(tws + T_Q), (const unsigned*)(tws + T_V), (const unsigned*)(tws + T_SG), (const unsigned*)(tws + T_LOGF), (bf16_t*)(tws + T_A), ap->in[I_GHG]};
        f32x4 S[8]; float ldacc[2] = {0.f, 0.f};
#pragma unroll
        for (int kt = 0; kt < 8; ++kt) S[kt] = (f32x4){0.f, 0.f, 0.f, 0.f};
        if (seg > 0) {
            LAS float* DECS = (LAS float*)(lds + H_DECS);
            for (int i = tid; i < seg * 128; i += 512) DECS[i] = fexp2(((const float*)(ws + WS_LD))[seq * 8 * 128 + i]);
            __syncthreads();
            const int g4 = lane >> 4;
            const float* slb = (const float*)(ws + WS_SLOC) + (size_t)(seq * 8) * 16384;
            int i = 0;
            for (; i + 1 < seg; i += 2) {
                f32x4 l0[8], l1[8];
#pragma unroll
                for (int kt = 0; kt < 8; ++kt)
#pragma unroll
                    for (int r = 0; r < 4; ++r) { l0[kt][r] = slb[(size_t)i * 16384 + ((wave * 8 + kt) * 4 + r) * 64 + lane]; l1[kt][r] = slb[(size_t)(i + 1) * 16384 + ((wave * 8 + kt) * 4 + r) * 64 + lane]; }
#pragma unroll
                for (int kt = 0; kt < 8; ++kt) { const f32x4 d0 = *(const LAS f32x4*)(DECS + i * 128 + 16 * kt + 4 * g4), d1 = *(const LAS f32x4*)(DECS + (i + 1) * 128 + 16 * kt + 4 * g4);
                    S[kt] = (S[kt] * d0 + l0[kt]) * d1 + l1[kt]; }
            }
            if (i < seg) {
                const float* sl = slb + (size_t)i * 16384;
#pragma unroll
                for (int kt = 0; kt < 8; ++kt) { const f32x4 dv = *(const LAS f32x4*)(DECS + i * 128 + 16 * kt + 4 * g4);
#pragma unroll
                    for (int r = 0; r < 4; ++r) S[kt][r] = S[kt][r] * dv[r] + sl[((wave * 8 + kt) * 4 + r) * 64 + lane]; }
            }
        }
        hgrn_chunks<HM_FINAL, 64>(lds, io, ((seq >> 2) & 3) * SEQ + seg * 1024, 16, seq & 3, S, ldacc, tid, wave, lane);
        if (seg == 7) state_store(ap->out + OFF_HP + (size_t)seq * 16384, S, wave, lane);
    }
    TEAM_BAR();

    {
        PHASE_BEGIN();
        pg8::Gemm g{(const bf16_t*)(tws + T_A), (const bf16_t*)(ws + WS_WOUT), TROWS, DM, DM}; pg8::StaticOrder S; S.init(128, DM, DM, G, tl, 4, nsp_of(team));
        pg8::EpiRow E{(bf16_t*)(tws + T_C), (float*)(tws + T_SS), (float*)(tws + T_SLAB), lds + pg8::EPI_STG_OFF};
        pg8::gemm_phase<pg8::EpiRow, pg8::StaticOrder, true, true>(lds, g, S, E);
    }
    TEAM_BAR();

    {
        PHASE_BEGIN();
        const int gw = tl * 8 + wave, NGW = G * 8;
        f32x4 g1[4], ig0[4];
#pragma unroll
        for (int j = 0; j < 4; ++j) { g1[j] = ((const f32x4*)ap->in[I_GPOST] + lane)[64 * j]; const f32x4 g0 = ((const f32x4*)ap->in[I_GPRE] + lane)[64 * j]; ig0[j] = (f32x4){1.0f / g0.x, 1.0f / g0.y, 1.0f / g0.z, 1.0f / g0.w}; }
        const bf16_t* YM = (const bf16_t*)(tws + T_C); const bf16_t* XN = (const bf16_t*)(tws + T_XB); bf16_t* X1 = (bf16_t*)(tws + T_X1); const float* SS = (const float*)(tws + T_SS);
        const float* RS0 = (const float*)(tws + T_RS0); float* RS2 = (float*)(tws + T_RS2);
        if (gw < 256 * nsp_of(team)) {
            const int r = MP / 2 + gw; const float* sl = (const float*)(tws + T_SLAB) + ((size_t)(gw >> 8) * 4 * 256 + (gw & 255)) * DM;
            const u32x2* xr = (const u32x2*)(XN + (size_t)r * DM) + lane; const float ir0 = 1.0f / RS0[r];
            f32x4 ym[4], v[4]; float q1 = 0.f;
#pragma unroll
            for (int j = 0; j < 4; ++j) { ym[j] = ((const f32x4*)sl + lane)[64 * j];
#pragma unroll
                for (int ks = 1; ks < 4; ++ks) ym[j] += ((const f32x4*)(sl + (size_t)ks * 256 * DM) + lane)[64 * j];
                const u32x2 xx = xr[64 * j]; v[j] = (f32x4){bf_lo(xx.x), bf_hi(xx.x), bf_lo(xx.y), bf_hi(xx.y)} * ig0[j] * ir0;
                q1 += (ym[j].x * ym[j].x + ym[j].y * ym[j].y) + (ym[j].z * ym[j].z + ym[j].w * ym[j].w); }
            const float rs1 = 1.0f / sqrtf(wave_sum(q1) * (1.0f / DM) + EPS); float q = 0.f;
#pragma unroll
            for (int j = 0; j < 4; ++j) { v[j] += ym[j] * rs1 * g1[j]; q += (v[j].x * v[j].x + v[j].y * v[j].y) + (v[j].z * v[j].z + v[j].w * v[j].w); }
            const float rs2 = 1.0f / sqrtf(wave_sum(q) * (1.0f / DM) + EPS);
            if (lane == 0) RS2[r] = rs2;
            u32x2* xrow = (u32x2*)(X1 + (size_t)r * DM) + lane;
#pragma unroll
            for (int j = 0; j < 4; ++j) { u32x2 xw; xw.x = cvt_pk_bf16(v[j].x * rs2, v[j].y * rs2); xw.y = cvt_pk_bf16(v[j].z * rs2, v[j].w * rs2); xrow[64 * j] = xw; }
        }
        for (int r0 = gw * RW; r0 < MP / 2; r0 += NGW * RW) {
            u32x2 xv[RW][4], y[RW][4]; float ssp[RW], ir0[RW];
            { const f32x4 sv = *(const f32x4*)(SS + (size_t)(r0 >> 4) * 256 + (lane & 15) * 16 + (r0 & 15)); ssp[0] = sv[0]; ssp[1] = sv[1]; ssp[2] = sv[2]; ssp[3] = sv[3]; }
#pragma unroll
            for (int i = 0; i < RW; ++i) { const int r = r0 + i; const u32x2* xr = (const u32x2*)(XN + (size_t)r * DM) + lane; const u32x2* yr = (const u32x2*)(YM + (size_t)r * DM) + lane;
                ir0[i] = RS0[r];
#pragma unroll
                for (int j = 0; j < 4; ++j) { xv[i][j] = xr[64 * j]; y[i][j] = yr[64 * j]; } }
#pragma unroll
            for (int i = 0; i < RW; ++i) { const int r = r0 + i;
                const float rs1 = 1.0f / sqrtf(sum16(ssp[i]) * (1.0f / DM) + EPS), irs = 1.0f / ir0[i]; float q = 0.f; f32x4 v[4];
#pragma unroll
                for (int j = 0; j < 4; ++j) { const u32x2 xx = xv[i][j], yy = y[i][j];
                    v[j].x = bf_lo(xx.x) * ig0[j].x * irs + bf_lo(yy.x) * rs1 * g1[j].x; v[j].y = bf_hi(xx.x) * ig0[j].y * irs + bf_hi(yy.x) * rs1 * g1[j].y;
                    v[j].z = bf_lo(xx.y) * ig0[j].z * irs + bf_lo(yy.y) * rs1 * g1[j].z; v[j].w = bf_hi(xx.y) * ig0[j].w * irs + bf_hi(yy.y) * rs1 * g1[j].w;
                    q += (v[j].x * v[j].x + v[j].y * v[j].y) + (v[j].z * v[j].z + v[j].w * v[j].w); }
                const float rs2 = 1.0f / sqrtf(wave_sum(q) * (1.0f / DM) + EPS);
                if (lane == 0) RS2[r] = rs2;
                u32x2* xrow = (u32x2*)(X1 + (size_t)r * DM) + lane;
#pragma unroll
                for (int j = 0; j < 4; ++j) { u32x2 xw; xw.x = cvt_pk_bf16(v[j].x * rs2, v[j].y * rs2); xw.y = cvt_pk_bf16(v[j].z * rs2, v[j].w * rs2); xrow[64 * j] = xw; } }
        }
    }
    TEAM_BAR();

    {
        PHASE_BEGIN();
        if (team == 1) {
            if (tid == 0) { const unsigned* wf = (const unsigned*)(ws + WS_CTL) + CW_WFLAG; unsigned sp = 0;
                while (!__hip_atomic_load(wf, __ATOMIC_RELAXED, __HIP_MEMORY_SCOPE_AGENT) && ++sp < (1u << 22)) __builtin_amdgcn_s_sleep(8);
                __builtin_amdgcn_fence(__ATOMIC_ACQUIRE, "agent"); }
            __syncthreads();
        }
        pg8::Gemm g{(const bf16_t*)(tws + T_X1), (const bf16_t*)(ws + WS_WGU), TROWS, NGU, DM}; pg8::StaticOrder S; S.init(128 + nsp_of(team), NGU, DM, G, tl, 0);
        pg8::EpiAct E{(bf16_t*)(tws + T_ACT)};
        pg8::gemm_phase<pg8::EpiAct, pg8::StaticOrder, true, true>(lds, g, S, E);
    }
    TEAM_BAR();

    {
        PHASE_BEGIN();
        pg8::Gemm g{(const bf16_t*)(tws + T_ACT), (const bf16_t*)(ws + WS_WD), TROWS, DM, DFF}; pg8::StaticOrder S; S.init(128, DM, DFF, G, tl, 11, nsp_of(team));
        pg8::EpiRow E{(bf16_t*)(tws + T_C), (float*)(tws + T_SS), (float*)(tws + T_SLAB5), lds + pg8::EPI_STG_OFF};
        pg8::gemm_phase<pg8::EpiRow, pg8::StaticOrder, true, true, true>(lds, g, S, E);
    }
    TEAM_BAR();

    {
        PHASE_BEGIN();
        const int gw = tl * 8 + wave, NGW = G * 8;
        f32x4 g3[4];
#pragma unroll
        for (int j = 0; j < 4; ++j) g3[j] = ((const f32x4*)ap->in[I_GPOSTF] + lane)[64 * j];
        const bf16_t* FB = (const bf16_t*)(tws + T_C); const bf16_t* X1 = (const bf16_t*)(tws + T_X1); const float* SS = (const float*)(tws + T_SS); const float* RS2 = (const float*)(tws + T_RS2); float* outp = ap->out;
        if (gw < 256 * nsp_of(team)) {
            const int r = MP / 2 + gw; const float* sl = (const float*)(tws + T_SLAB5) + ((size_t)(gw >> 8) * 11 * 256 + (gw & 255)) * DM;
            const u32x2* xr = (const u32x2*)(X1 + (size_t)r * DM) + lane;
            f32x4 fm[4]; float q1 = 0.f;
#pragma unroll
            for (int j = 0; j < 4; ++j) { fm[j] = ((const f32x4*)sl + lane)[64 * j];
#pragma unroll
                for (int ks = 1; ks < 11; ++ks) fm[j] += ((const f32x4*)(sl + (size_t)ks * 256 * DM) + lane)[64 * j];
                q1 += (fm[j].x * fm[j].x + fm[j].y * fm[j].y) + (fm[j].z * fm[j].z + fm[j].w * fm[j].w); }
            const float rs3 = 1.0f / sqrtf(wave_sum(q1) * (1.0f / DM) + EPS), ir2 = 1.0f / RS2[r];
            f32x4* orow = (f32x4*)(outp + OFF_Y + (size_t)team_row(team, r) * DM) + lane;
#pragma unroll
            for (int j = 0; j < 4; ++j) { const u32x2 xx = xr[64 * j]; f32x4 x;
                x.x = bf_lo(xx.x) * ir2 + fm[j].x * rs3 * g3[j].x; x.y = bf_hi(xx.x) * ir2 + fm[j].y * rs3 * g3[j].y; x.z = bf_lo(xx.y) * ir2 + fm[j].z * rs3 * g3[j].z; x.w = bf_hi(xx.y) * ir2 + fm[j].w * rs3 * g3[j].w;
                orow[64 * j] = x; }
        }
        unsigned* ctlw = (unsigned*)(ws + WS_CTL);
        if (tl == 0 && tid == 0) __hip_atomic_store(ctlw + CW_FLAG + 64 * team, 1u, __ATOMIC_RELAXED, __HIP_MEMORY_SCOPE_AGENT);
        ROWQ_BEGIN(ctlw + CW_ROWQ + 64 * team)
            p5b_rows(tws, team, r0, outp, g3, lane);
        ROWQ_END()
        {
            const int ot = team ^ 1;
            if (tid == 0) { unsigned sp = 0, ok = 0;
                for (;;) { ok = __hip_atomic_load(ctlw + CW_FLAG + 64 * ot, __ATOMIC_RELAXED, __HIP_MEMORY_SCOPE_AGENT); if (ok || ++sp > (1u << 16)) break; __builtin_amdgcn_s_sleep(8); }
                __builtin_amdgcn_fence(__ATOMIC_ACQUIRE, "agent"); asm volatile("s_waitcnt vmcnt(0)" ::: "memory");
                MISC[9] = ok; }
            __syncthreads();
            if (MISC[9]) {
                unsigned char* otw = ws + WS_TEAM + (size_t)ot * TEAM_BYTES;
                ROWQ_BEGIN(ctlw + CW_ROWQ + 64 * ot)
                    p5b_rows(otw, ot, r0, outp, g3, lane);
                ROWQ_END()
            }
        }
    }
}

extern "C" void kernel_launch(void* const* d_in, const int* in_sizes, int n_in, void* d_out, int out_size, void* d_ws, size_t ws_size, hipStream_t stream) {
    static int grid = 0;
    if (grid == 0) {
        if (n_in != 17 || in_sizes[0] != MP * DM || ws_size < WS_END) { fprintf(stderr, "kernel_launch: unexpected shapes (n_in %d, in0 %d, ws %zu); nothing launched\n", n_in, n_in > 0 ? in_sizes[0] : -1, ws_size); grid = -1; return; }
        int dev = 0, cus = 0, per_cu = 0;
        hipGetDevice(&dev);
        hipDeviceGetAttribute(&cus, hipDeviceAttributeMultiprocessorCount, dev);
        if (hipFuncSetAttribute((const void*)fwd_megakernel, hipFuncAttributeMaxDynamicSharedMemorySize, LDS_BYTES) != hipSuccess) { fprintf(stderr, "kernel_launch: hipFuncSetAttribute failed\n"); grid = -1; return; }
        hipOccupancyMaxActiveBlocksPerMultiprocessor(&per_cu, (const void*)fwd_megakernel, 512, LDS_BYTES);
        if (per_cu < 1) { fprintf(stderr, "kernel_launch: occupancy query says %d blocks per CU\n", per_cu); per_cu = 1; }
        (void)hipGetLastError();
        grid = cus;
        if (grid != 256) fprintf(stderr, "kernel_launch: %d CUs; this kernel is laid out for 256\n", grid);
        if (grid > 256) grid = 256;
    }
    if (grid < 0) return;
    if (hipMemsetAsync((char*)d_ws + WS_CTL, 0, CTL_ZERO_BYTES, stream) != hipSuccess) { fprintf(stderr, "kernel_launch: memset failed\n"); return; }
    Args a{};
    for (int i = 0; i < 17; ++i) a.in[i] = (const float*)d_in[i];
    a.out = (float*)d_out; a.ws = (unsigned char*)d_ws;
    void* args[] = {&a};
    hipError_t e = hipLaunchCooperativeKernel((const void*)fwd_megakernel, dim3(grid), dim3(512), args, LDS_BYTES, stream);
    if (e != hipSuccess) fprintf(stderr, "cooperative launch failed: %s (grid %d)\n", hipGetErrorString(e), grid);
}
```

```cpp
#include <hip/hip_runtime.h>
#include <hip/hip_cooperative_groups.h>
#include <cstdio>
#include <cstdint>
namespace cg = cooperative_groups;

#define LAS __attribute__((address_space(3)))
typedef unsigned short bf16_t;
typedef short bf16x8 __attribute__((ext_vector_type(8)));
typedef short bf16x4 __attribute__((ext_vector_type(4)));
typedef float f32x4 __attribute__((ext_vector_type(4)));
typedef float f32x2 __attribute__((ext_vector_type(2)));
typedef unsigned u32x4 __attribute__((ext_vector_type(4)));
typedef unsigned u32x2 __attribute__((ext_vector_type(2)));
typedef _Float16 f16x2 __attribute__((ext_vector_type(2)));

constexpr int DM = 1024, MP = 65536, MS = 512, MT = MP + MS;
constexpr int SEQ = 8192, DSEQ = 32, NBP = 8, NBS = 16;
constexpr int DPOOL = 512, DHG = 512, DIN = 2560, DFF = 2816, NGU = 2 * DFF;
constexpr float EPS = 1e-6f;
constexpr float LOG2E = 1.4426950408889634f, LN2 = 0.6931471805599453f;
constexpr size_t OFF_Y = 0, OFF_PP = (size_t)MT * DM, OFF_HP = OFF_PP + 8 * 15 * 512, OFF_PS = OFF_HP + 8 * 4 * 16384, OFF_HS = OFF_PS + 16 * 15 * 512;
constexpr size_t MiB = 1u << 20;
constexpr size_t WS_CTL = 0, CTL_ZERO_BYTES = 65536;
constexpr size_t WS_WIN = 2 * MiB;
constexpr size_t WS_WOUT = 8 * MiB;
constexpr size_t WS_WGU = 10 * MiB;
constexpr size_t WS_WD = 22 * MiB;
constexpr size_t WS_WP = 28 * MiB;
constexpr size_t WS_LB = 29 * MiB;
constexpr size_t WS_LD = 30 * MiB;
constexpr size_t WS_SLOC = 32 * MiB;
constexpr int TROWS = MP / 2 + MS;
__host__ __device__ constexpr int nsp_of(int team) { return team == 0 ? 2 : 0; }
__host__ __device__ constexpr int trows_of(int team) { return MP / 2 + 256 * nsp_of(team); }
constexpr size_t WS_TEAM = 64 * MiB, TEAM_BYTES = 480 * MiB;
constexpr size_t T_A = 0;
constexpr size_t T_C = 65 * MiB;
constexpr size_t T_SS = 130 * MiB;
constexpr size_t T_RS0 = T_SS + (size_t)(2.25 * 1048576);
constexpr size_t T_RS2 = T_SS + (size_t)(2.50 * 1048576);
constexpr size_t T_B = 133 * MiB;
constexpr size_t PART_B = (size_t)TROWS * 512 * 2;
constexpr size_t T_U = T_B, T_Q = T_B + PART_B, T_KIN = T_B + 2 * PART_B, T_V = T_B + 3 * PART_B, T_SG = T_B + 4 * PART_B, T_LOGF = T_B + 5 * PART_B;
constexpr size_t T_ACT = T_B;
constexpr size_t T_END = T_LOGF + (size_t)TROWS * 512 * 2;
constexpr size_t T_X1 = 328 * MiB;
constexpr size_t T_SLAB = 393 * MiB;
constexpr size_t T_XB = 405 * MiB;
constexpr size_t T_SLAB5 = T_XB;
constexpr size_t WS_END = WS_TEAM + 2 * TEAM_BYTES;
static_assert(T_END <= T_X1 && T_X1 + (size_t)TROWS * 2048 <= T_SLAB && T_SLAB + (size_t)2 * 4 * 256 * 1024 * 4 <= T_XB && T_XB + (size_t)TROWS * 2048 <= TEAM_BYTES && T_ACT + (size_t)TROWS * DFF * 2 <= T_END &&
              (size_t)2 * 11 * 256 * 1024 * 4 <= (size_t)TROWS * 2048 &&
              WS_END <= 1024 * MiB && T_A + (size_t)TROWS * 2048 <= T_C && T_C + (size_t)TROWS * 2048 <= T_SS && T_SS + (size_t)TROWS * 64 <= T_RS0 && T_RS2 + (size_t)TROWS * 4 <= T_B, "ws map");

__device__ __forceinline__ unsigned cvt_pk_bf16(float lo, float hi) { unsigned r; asm volatile("v_cvt_pk_bf16_f32 %0, %1, %2" : "=v"(r) : "v"(lo), "v"(hi)); return r; }
__device__ __forceinline__ unsigned pk_f16(float lo, float hi) { const f16x2 h = (f16x2){(_Float16)lo, (_Float16)hi}; return __builtin_bit_cast(unsigned, h); }
__device__ __forceinline__ f32x2 unpk_f16(unsigned u) { const f16x2 h = __builtin_bit_cast(f16x2, u); return (f32x2){(float)h.x, (float)h.y}; }
__device__ __forceinline__ float bf_lo(unsigned u) { return __builtin_bit_cast(float, u << 16); }
__device__ __forceinline__ float bf_hi(unsigned u) { return __builtin_bit_cast(float, u & 0xffff0000u); }
__device__ __forceinline__ float fexp2(float x) { return __builtin_amdgcn_exp2f(x); }
__device__ __forceinline__ float flog2(float x) { return __builtin_amdgcn_logf(x); }
__device__ __forceinline__ float frcp(float x) { return __builtin_amdgcn_rcpf(x); }
__device__ __forceinline__ float fsigmoid(float x) { return frcp(1.0f + fexp2(-LOG2E * x)); }
__device__ __forceinline__ float fsilu(float x) { return x * fsigmoid(x); }
__device__ __forceinline__ float wave_sum(float v) {
#pragma unroll
    for (int o = 1; o < 64; o <<= 1) v += __shfl_xor(v, o);
    return v;
}

namespace pg8 {
#define PG8_LAS __attribute__((address_space(3)))
constexpr int BM = 256, BK = 64, HALF = 128, HTB = HALF * BK * 2, STAGE_BYTES = 8 * HTB, NXT = 4  , WGM = 8;
constexpr int NPP = 256  , TPP = 128  ;
__host__ __device__ __forceinline__ int lds_byte(int r, int c) { const int st = (r >> 4) * 2 + (c >> 5), rr = r & 15, cc = c & 31, ob = rr * 64 + cc * 2; return st * 1024 + (ob ^ (((ob >> 9) & 1) << 5)); }
__host__ __device__ __forceinline__ void stage_rc(int b, int& R, int& C) { const int st = b / 1024, sb = b % 1024, swz = sb ^ (((sb >> 9) & 1) << 5); R = (st >> 1) * 16 + swz / 64; C = (st & 1) * 32 + (swz % 64) / 2; }
__host__ __device__ __forceinline__ int perm32(int rho) { const int n = rho >> 4, i = rho & 15; return 8 * (i >> 2) + 4 * n + (i & 3); }
struct Unit { int pm, pn, kt0, nkt, slab; };
struct Gemm { const bf16_t* A; const bf16_t* Bt; int M, N, K; };
template <int NN, int NSL>
struct StaticOrder {
    static constexpr int nN = NN, nsl = NSL;
    int nM, nwg, G, c, nkt, nsp;
    __host__ __device__ void init(int nM_, int N, int K, int G_, int c_, int nsl_, int nsp_ = 0) { nM = nM_; nwg = nM * nN; G = G_; c = c_; nkt = K / BK; nsp = nsp_; (void)N; (void)nsl_; }
    __host__ __device__ bool next(int i, Unit& u) const {
        const long L = (long)i * G + c;
        if (L >= nwg) {
            if constexpr (NSL == 0) return false;
            else { int s = (int)(L - nwg); if (s >= nsp * nsl * nN) return false;
                const int sp = s / (nsl * nN); s -= sp * nsl * nN;
                u.pm = 128 + sp; u.pn = s % nN; u.kt0 = 4 * (s / nN); u.nkt = 4; u.slab = 1 + sp * nsl + s / nN; return true; } }
        int wgid = (int)L; { const int q = nwg / NXT, r = nwg % NXT, xcd = wgid % NXT, off = wgid / NXT; wgid = (xcd < r ? xcd * (q + 1) : r * (q + 1) + (xcd - r) * q) + off; }
        constexpr int nig = WGM * nN; const int gid = wgid / nig, fm = gid * WGM, rem = wgid - gid * nig;
        if (nM - fm >= WGM) { u.pm = fm + (rem % WGM); u.pn = rem / WGM; }
        else { const int gsz = nM - fm; u.pm = fm + (rem % gsz); u.pn = rem / gsz; }
        u.kt0 = 0; u.nkt = nkt; u.slab = 0; return true;
    }
    __device__ __forceinline__ void a_ready(const Unit&) const {}
    __device__ __forceinline__ void done(const Unit&) const {}
};

constexpr int EPI_STG_OFF = 131072 + 256, EPI_STG_WAVE = 16 * 144;
__device__ __forceinline__ void store_lines16(PG8_LAS unsigned char* T, const u32x4& w0, const u32x4& w1, bf16_t* dst, size_t pitch, int fr, int fq) {
    *(PG8_LAS u32x4*)(T + fr * 144 + 16 * fq) = w0; *(PG8_LAS u32x4*)(T + fr * 144 + 64 + 16 * fq) = w1;
    asm volatile("" ::: "memory");
    const int l = fq * 16 + fr, rr = l >> 3, ch = l & 7;
    const u32x4 a = *(const PG8_LAS u32x4*)(T + rr * 144 + 16 * ch), b = *(const PG8_LAS u32x4*)(T + (rr + 8) * 144 + 16 * ch);
    asm volatile("" ::: "memory");
    *(u32x4*)(dst + (size_t)rr * pitch + 8 * ch) = a; *(u32x4*)(dst + (size_t)(rr + 8) * pitch + 8 * ch) = b;
}

struct EpiZ {
    static constexpr bool PERM = true, AFTER_DRAIN = false;
    unsigned char* tws; const float* LB; PG8_LAS unsigned char* stg;
    __device__ __forceinline__ void operator()(const f32x4 (&acc)[2][2][4][2], const Unit& u, int wr, int wc, int fr, int fq) const {
        bf16_t* const U = (bf16_t*)(tws + T_U); bf16_t* const Q = (bf16_t*)(tws + T_Q); bf16_t* const V = (bf16_t*)(tws + T_V); bf16_t* const SG = (bf16_t*)(tws + T_SG);
        bf16_t* const LOGF = (bf16_t*)(tws + T_LOGF);
        PG8_LAS unsigned char* T = stg + (wr * 4 + wc) * EPI_STG_WAVE;
        const int rowg = u.pm * BM + wr * 64;
        const int type = u.pn >> 1;
        const int colw = (u.pn & 1) * 256 + wc * 64;
        if (type == 2) {
            f32x4 lbv[2][2];
#pragma unroll
            for (int bj = 0; bj < 2; ++bj) { lbv[bj][0] = *(const f32x4*)(LB + colw + bj * 32 + 8 * fq); lbv[bj][1] = *(const f32x4*)(LB + colw + bj * 32 + 8 * fq + 4); }
#pragma unroll
            for (int ai = 0; ai < 2; ++ai)
#pragma unroll
                for (int m = 0; m < 4; ++m) { const size_t ro = (size_t)(rowg + ai * HALF + m * 16) * 512 + colw;
                    u32x4 lw[2];
#pragma unroll
                    for (int bj = 0; bj < 2; ++bj) { f32x4 lf[2];
#pragma unroll
                        for (int n = 0; n < 2; ++n)
#pragma unroll
                            for (int h = 0; h < 2; ++h) {
                                const f32x2 z = (f32x2){acc[ai][bj][m][n][2 * h], acc[ai][bj][m][n][2 * h + 1]}, lb = (f32x2){lbv[bj][n][2 * h], lbv[bj][n][2 * h + 1]};
                                const f32x2 t = z * (f32x2){-LOG2E, -LOG2E}, d = (f32x2){fexp2(t.x), fexp2(t.y)} + (f32x2){1.0f, 1.0f};
                                const f32x2 sg = (f32x2){frcp(d.x), frcp(d.y)}, fg = ((f32x2){1.0f, 1.0f} - lb) * sg + lb;
                                lf[n][2 * h] = flog2(fg.x); lf[n][2 * h + 1] = flog2(fg.y); }
                        lw[bj].x = pk_f16(lf[0][0], lf[0][1]); lw[bj].y = pk_f16(lf[0][2], lf[0][3]); lw[bj].z = pk_f16(lf[1][0], lf[1][1]); lw[bj].w = pk_f16(lf[1][2], lf[1][3]); }
                    store_lines16(T, lw[0], lw[1], LOGF + ro, 512, fr, fq);
                    asm volatile("" ::: "memory"); }
        } else {
            bf16_t* O = type == 0 ? U : (type == 1 ? Q : (type == 3 ? V : SG));
            const bool act = (type == 1) || (type == 4);
#pragma unroll
            for (int ai = 0; ai < 2; ++ai)
#pragma unroll
                for (int m = 0; m < 4; ++m) { const size_t ro = (size_t)(rowg + ai * HALF + m * 16) * 512 + colw;
                    u32x4 w[2];
#pragma unroll
                    for (int bj = 0; bj < 2; ++bj) { f32x4 v0 = acc[ai][bj][m][0], v1 = acc[ai][bj][m][1];
                        if (act) {
#pragma unroll
                            for (int h = 0; h < 2; ++h) {
                                const f32x2 za = (f32x2){v0[2 * h], v0[2 * h + 1]}, zb = (f32x2){v1[2 * h], v1[2 * h + 1]};
                                const f32x2 ta = za * (f32x2){-LOG2E, -LOG2E}, tb = zb * (f32x2){-LOG2E, -LOG2E};
                                const f32x2 da = (f32x2){fexp2(ta.x), fexp2(ta.y)} + (f32x2){1.0f, 1.0f}, db = (f32x2){fexp2(tb.x), fexp2(tb.y)} + (f32x2){1.0f, 1.0f};
                                const f32x2 ra = za * (f32x2){frcp(da.x), frcp(da.y)}, rb = zb * (f32x2){frcp(db.x), frcp(db.y)};
                                v0[2 * h] = ra.x; v0[2 * h + 1] = ra.y; v1[2 * h] = rb.x; v1[2 * h + 1] = rb.y; } }
                        w[bj].x = cvt_pk_bf16(v0[0], v0[1]); w[bj].y = cvt_pk_bf16(v0[2], v0[3]); w[bj].z = cvt_pk_bf16(v1[0], v1[1]); w[bj].w = cvt_pk_bf16(v1[2], v1[3]); }
                    store_lines16(T, w[0], w[1], O + ro, 512, fr, fq);
                    asm volatile("" ::: "memory"); }
        }
    }
};
struct EpiAct {
    static constexpr bool PERM = true, AFTER_DRAIN = false;
    bf16_t* ACT;
    __device__ __forceinline__ void operator()(const f32x4 (&acc)[2][2][4][2], const Unit& u, int wr, int wc, int fr, int fq) const {
        const int kt = u.pn * 2 + (wc >> 1);
        const int ob = fr * 64 + fq * 16, inb = ob ^ (((ob >> 9) & 1) << 5);
#pragma unroll
        for (int ai = 0; ai < 2; ++ai)
#pragma unroll
            for (int m = 0; m < 4; ++m) {
                unsigned char* p = (unsigned char*)ACT + ((size_t)(u.pm * 2 + ai) * (DFF / 64) + kt) * 16384 + ((wr * 4 + m) * 2 + (wc & 1)) * 1024 + inb;
                f32x4 a0, a1;
#pragma unroll
                for (int n = 0; n < 2; ++n)
#pragma unroll
                    for (int h = 0; h < 2; ++h) {
                        const f32x2 gg = (f32x2){acc[ai][0][m][n][2 * h], acc[ai][0][m][n][2 * h + 1]}, uu = (f32x2){acc[ai][1][m][n][2 * h], acc[ai][1][m][n][2 * h + 1]};
                        const f32x2 pr = gg * uu, dd = (f32x2){fexp2(gg.x), fexp2(gg.y)} + (f32x2){1.0f, 1.0f};
                        const f32x2 rr = pr * (f32x2){frcp(dd.x), frcp(dd.y)};
                        if (n == 0) { a0[2 * h] = rr.x; a0[2 * h + 1] = rr.y; } else { a1[2 * h] = rr.x; a1[2 * h + 1] = rr.y; } }
                u32x4 w; w.x = cvt_pk_bf16(a0[0], a0[1]); w.y = cvt_pk_bf16(a0[2], a0[3]); w.z = cvt_pk_bf16(a1[0], a1[1]); w.w = cvt_pk_bf16(a1[2], a1[3]);
                *(u32x4*)p = w; }
    }
};
struct EpiRow {
    static constexpr bool PERM = true, AFTER_DRAIN = false;
    bf16_t* O; float* SS; float* SLAB; PG8_LAS unsigned char* stg;
    __device__ __forceinline__ void operator()(const f32x4 (&acc)[2][2][4][2], const Unit& u, int wr, int wc, int fr, int fq) const {
        if (u.slab) {
            float* base = SLAB + (size_t)(u.slab - 1) * 256 * DM + u.pn * BM + wc * 64 + 8 * fq;
#pragma unroll
            for (int ai = 0; ai < 2; ++ai)
#pragma unroll
                for (int m = 0; m < 4; ++m) { float* p = base + (size_t)(wr * 64 + fr + ai * HALF + m * 16) * DM;
#pragma unroll
                    for (int bj = 0; bj < 2; ++bj) { *(f32x4*)(p + bj * 32) = acc[ai][bj][m][0]; *(f32x4*)(p + bj * 32 + 4) = acc[ai][bj][m][1]; }
                    asm volatile("" ::: "memory"); }
            return;
        }
        PG8_LAS unsigned char* T = stg + (wr * 4 + wc) * EPI_STG_WAVE;
        const int rowg = u.pm * BM + wr * 64, colw = u.pn * BM + wc * 64;
        float sq[2][4];
#pragma unroll
        for (int ai = 0; ai < 2; ++ai)
#pragma unroll
            for (int m = 0; m < 4; ++m) { const int row = rowg + ai * HALF + m * 16; f32x2 s2 = (f32x2){0.f, 0.f}; u32x4 w[2];
#pragma unroll
                for (int bj = 0; bj < 2; ++bj) { const f32x4 v0 = acc[ai][bj][m][0], v1 = acc[ai][bj][m][1];
                    const f32x2 p0 = (f32x2){v0[0], v0[1]}, p1 = (f32x2){v0[2], v0[3]}, p2 = (f32x2){v1[0], v1[1]}, p3 = (f32x2){v1[2], v1[3]};
                    s2 += p0 * p0; s2 += p1 * p1; s2 += p2 * p2; s2 += p3 * p3;
                    w[bj].x = cvt_pk_bf16(v0[0], v0[1]); w[bj].y = cvt_pk_bf16(v0[2], v0[3]); w[bj].z = cvt_pk_bf16(v1[0], v1[1]); w[bj].w = cvt_pk_bf16(v1[2], v1[3]); }
                store_lines16(T, w[0], w[1], O + (size_t)row * DM + colw, DM, fr, fq);
                sq[ai][m] = s2.x + s2.y; }
        const bool hi2 = (fq & 2) != 0, hi1 = (fq & 1) != 0;
        float u4[4];
#pragma unroll
        for (int i = 0; i < 4; ++i) { const float keep = hi2 ? sq[1][i] : sq[0][i], send = hi2 ? sq[0][i] : sq[1][i]; u4[i] = keep + __shfl_xor(send, 32); }
#pragma unroll
        for (int j = 0; j < 2; ++j) { const float keep = hi1 ? u4[2 + j] : u4[j], send = hi1 ? u4[j] : u4[2 + j]; const float tot = keep + __shfl_xor(send, 16);
            const int row = rowg + (fq >> 1) * HALF + (2 * (fq & 1) + j) * 16;
            SS[(size_t)(row >> 4) * 256 + (u.pn * 4 + wc) * 16 + fr] = tot; }
    }
};

template <class Epi, class Sched, bool ALIGN_EPI = false, bool SP2 = false, bool ATILED = false>
__device__ __forceinline__ void gemm_phase(PG8_LAS unsigned char* lds, const Gemm g, const Sched& S, const Epi& E) {
    int tid = threadIdx.x; asm volatile("" : "+v"(tid));
    const int wid = __builtin_amdgcn_readfirstlane(tid >> 6), lane = tid & 63, wr = wid >> 2, wc = wid & 3, fr = lane & 15, fq = lane >> 4;
    const int K = g.K;
    unsigned voffA[2], voffB[2];
#pragma unroll
    for (int i = 0; i < 2; ++i) { int R, C; stage_rc(tid * 16 + i * 8192, R, C);
        voffA[i] = ATILED ? (unsigned)(tid * 16 + i * 8192) : (unsigned)(R * K + C) * 2u; voffB[i] = (unsigned)(tid * 16 + i * 8192); }
    const size_t kstep = ATILED ? (size_t)16384 : (size_t)(BK * 2);
    const size_t hstep = ATILED ? (size_t)(K / BK) * 16384 : (size_t)HALF * K * 2;
    const size_t kstepB = 16384, qstep = (size_t)(K / BK) * 16384, tstepB = 2 * qstep;
    const size_t tstep = 2 * hstep;
    const unsigned ldsw = (unsigned)wid * 1024u;
    const int aoff = lds_byte(wr * 64 + fr, fq * 8), boff = lds_byte(wc * 32 + fr, fq * 8);
#define PG8_SA(b, h) (((b) * 2 + (h)) * HTB)
#define PG8_SB(b, h) ((4 + (b) * 2 + (h)) * HTB)
#define PG8_STAGE(bufoff, gbase, voff) do { _Pragma("unroll") for (int _i = 0; _i < 2; ++_i) \
        __builtin_amdgcn_global_load_lds((const unsigned*)((const char*)(gbase) + (voff)[_i]), (PG8_LAS unsigned*)(lds + (bufoff) + ldsw + _i * 8192), 16, 0, 0); } while (0)
#define PG8_LDA(dst, b, h) do { _Pragma("unroll") for (int m = 0; m < 4; ++m) _Pragma("unroll") for (int k = 0; k < 2; ++k) dst[m][k] = *(const PG8_LAS bf16x8*)(lds + PG8_SA(b, h) + aoff + m * 2048 + k * 1024); } while (0)
#define PG8_LDB(dst, b, h) do { _Pragma("unroll") for (int n = 0; n < 2; ++n) _Pragma("unroll") for (int k = 0; k < 2; ++k) dst[n][k] = *(const PG8_LAS bf16x8*)(lds + PG8_SB(b, h) + boff + n * 2048 + k * 1024); } while (0)
#define PG8_MMA(ai, bj, At, Bt) do { __builtin_amdgcn_s_setprio(1); _Pragma("unroll") for (int m = 0; m < 4; ++m) _Pragma("unroll") for (int n = 0; n < 2; ++n) _Pragma("unroll") for (int k = 0; k < 2; ++k) \
        acc[ai][bj][m][n] = __builtin_amdgcn_mfma_f32_16x16x32_bf16(Bt[n][k], At[m][k], acc[ai][bj][m][n], 0, 0, 0); __builtin_amdgcn_s_setprio(0); } while (0)
#define PG8_MMAZ(ai, bj, At, Bt) do { __builtin_amdgcn_s_setprio(1); _Pragma("unroll") for (int m = 0; m < 4; ++m) _Pragma("unroll") for (int n = 0; n < 2; ++n) { \
        acc[ai][bj][m][n] = __builtin_amdgcn_mfma_f32_16x16x32_bf16(Bt[n][0], At[m][0], (f32x4){0.f, 0.f, 0.f, 0.f}, 0, 0, 0); \
        acc[ai][bj][m][n] = __builtin_amdgcn_mfma_f32_16x16x32_bf16(Bt[n][1], At[m][1], acc[ai][bj][m][n], 0, 0, 0); } __builtin_amdgcn_s_setprio(0); } while (0)
#define PG8_WAIT_V(n) asm volatile("s_waitcnt vmcnt(" #n ")" ::: "memory")
#define PG8_WAIT_L(n) asm volatile("s_waitcnt lgkmcnt(" #n ")" ::: "memory")
#define PG8_BAR __builtin_amdgcn_s_barrier()
#define PG8_SCHED __builtin_amdgcn_sched_barrier(0)
    Unit cur, nxt; int ui = 0;
    if (!S.next(0, cur)) return;
    f32x4 acc[2][2][4][2];
    bf16x8 At[4][2], B0[2][2], B1[2][2];
    const char* cA = (const char*)g.A + (size_t)cur.pm * tstep + (size_t)cur.kt0 * kstep; const char* cB = (const char*)g.Bt + (size_t)cur.pn * tstepB + (size_t)cur.kt0 * kstepB;
    S.a_ready(cur);
    if constexpr (SP2) {
        PG8_STAGE(PG8_SB(0, 0), cB, voffB); PG8_STAGE(PG8_SB(0, 1), cB + qstep, voffB); PG8_STAGE(PG8_SA(0, 0), cA, voffA); PG8_STAGE(PG8_SA(0, 1), cA + hstep, voffA);
        if (wr == 1) PG8_BAR;
        PG8_WAIT_V(2); PG8_BAR;
        PG8_STAGE(PG8_SB(1, 0), cB + kstepB, voffB); PG8_STAGE(PG8_SA(1, 0), cA + kstep, voffA); PG8_STAGE(PG8_SB(1, 1), cB + qstep + kstepB, voffB);
        PG8_WAIT_V(6); PG8_BAR;
    } else {
        PG8_STAGE(PG8_SB(0, 0), cB, voffB); PG8_STAGE(PG8_SA(0, 0), cA, voffA); PG8_STAGE(PG8_SB(0, 1), cB + qstep, voffB); PG8_STAGE(PG8_SA(0, 1), cA + hstep, voffA);
        if (wr == 1) PG8_BAR;
        PG8_WAIT_V(4); PG8_BAR;
        PG8_STAGE(PG8_SB(1, 0), cB + kstepB, voffB); PG8_STAGE(PG8_SA(1, 0), cA + kstep, voffA); PG8_STAGE(PG8_SB(1, 1), cB + qstep + kstepB, voffB);
        PG8_WAIT_V(6); PG8_BAR;
    }
    for (;;) {
        const bool has_next = S.next(ui + 1, nxt);
        const char* nA = has_next ? (const char*)g.A + (size_t)nxt.pm * tstep + (size_t)nxt.kt0 * kstep : cA; const char* nB = has_next ? (const char*)g.Bt + (size_t)nxt.pn * tstepB + (size_t)nxt.kt0 * kstepB : cB;
        const int nt = cur.nkt;
        static_assert(SP2, "only the SP2 super-phase schedule is kept");
#define PG8_KBODY(M01) { \
            const bool last = (t == nt - 2); \
            const char* a1 = cA + (size_t)(t + 1) * kstep; \
            const char* a2 = last ? nA : cA + (size_t)(t + 2) * kstep; const char* b2 = last ? nB : cB + (size_t)(t + 2) * kstepB; \
            const char* a3 = a2 + kstep; const char* b3 = b2 + kstepB; \
            if (last && has_next) S.a_ready(nxt); \
            PG8_LDB(B0, 0, 0); PG8_LDB(B1, 0, 1); PG8_SCHED; PG8_LDA(At, 0, 0); PG8_STAGE(PG8_SA(1, 1), a1 + hstep, voffA); \
            PG8_WAIT_V(8); PG8_WAIT_L(0); PG8_BAR; M01(0, 0, At, B0); M01(0, 1, At, B1); PG8_BAR; PG8_SCHED; \
            PG8_LDA(At, 0, 1); PG8_STAGE(PG8_SB(0, 0), b2, voffB); PG8_STAGE(PG8_SB(0, 1), b2 + qstep, voffB); PG8_STAGE(PG8_SA(0, 0), a2, voffA); \
            PG8_WAIT_V(8); PG8_WAIT_L(0); PG8_BAR; M01(1, 0, At, B0); M01(1, 1, At, B1); PG8_BAR; PG8_SCHED; \
            PG8_LDB(B0, 1, 0); PG8_LDB(B1, 1, 1); PG8_SCHED; PG8_LDA(At, 1, 0); PG8_STAGE(PG8_SA(0, 1), a2 + hstep, voffA); \
            PG8_WAIT_V(8); PG8_WAIT_L(0); PG8_BAR; PG8_MMA(0, 0, At, B0); PG8_MMA(0, 1, At, B1); PG8_BAR; PG8_SCHED; \
            PG8_LDA(At, 1, 1); PG8_STAGE(PG8_SB(1, 0), b3, voffB); PG8_STAGE(PG8_SB(1, 1), b3 + qstep, voffB); PG8_STAGE(PG8_SA(1, 0), a3, voffA); \
            PG8_WAIT_V(8); PG8_WAIT_L(0); PG8_BAR; PG8_MMA(1, 0, At, B0); PG8_MMA(1, 1, At, B1); PG8_BAR; PG8_SCHED; }
        { const int t = 0; PG8_KBODY(PG8_MMAZ) }
        for (int t = 2; t < nt; t += 2) PG8_KBODY(PG8_MMA)
#undef PG8_KBODY
        if constexpr (ALIGN_EPI) { if (wr == 0) PG8_BAR; }
        asm volatile("" : "+s"(cur.pm), "+s"(cur.pn), "+s"(cur.slab));
        if constexpr (!Epi::AFTER_DRAIN) { int efr = fr, efq = fq; asm volatile("" : "+v"(efr), "+v"(efq));
            E(acc, cur, wr, wc, efr, efq); S.done(cur); }
        if (!has_next) break;
        cur = nxt; cA = nA; cB = nB; ++ui;
        if constexpr (ALIGN_EPI) { if (wr == 1) PG8_BAR; }
    }
    PG8_WAIT_V(0);
    if constexpr (!ALIGN_EPI) { if (wr == 0) PG8_BAR; }
    PG8_BAR;
#undef PG8_SA
#undef PG8_SB
#undef PG8_STAGE
#undef PG8_LDA
#undef PG8_LDB
#undef PG8_MMA
#undef PG8_MMAZ
#undef PG8_WAIT_V
#undef PG8_WAIT_L
#undef PG8_BAR
#undef PG8_SCHED
}
}

struct Args {
    const float* in[17];
    float* out; unsigned char* ws;
};
static_assert(sizeof(Args) == 19 * 8, "no padding");
typedef const __attribute__((address_space(4))) Args* ArgP;
__device__ __forceinline__ ArgP get_args() { ArgP p = (ArgP)__builtin_amdgcn_kernarg_segment_ptr(); asm volatile("" : "+s"(p)); return p; }
__device__ __forceinline__ int opaque_tid() { int t = threadIdx.x; asm volatile("" : "+v"(t)); return t; }
enum { I_XP = 0, I_XS, I_CACHE, I_STATE, I_GPRE, I_WIN, I_WPOOL, I_PSCALE, I_LBL, I_GHG, I_WOUT, I_GPOST, I_GPFFN, I_WG, I_WU, I_WD, I_GPOSTF };

constexpr int LDS_BYTES = 151552;

__device__ __forceinline__ void transpose_load(f32x4 (&v)[8], const float* W, int N, int item, int lane) {
    const int nblk = N / 32, kb = item / nblk, nb = item % nblk, k0 = 64 * kb, n0 = 32 * nb, rr = lane >> 3, cc = lane & 7;
#pragma unroll
    for (int i = 0; i < 8; ++i) v[i] = *(const f32x4*)(W + (size_t)(k0 + 8 * i + rr) * N + n0 + 4 * cc);
}
template <int MODE>
__device__ __forceinline__ void transpose_finish(const f32x4 (&v)[8], int K, int N, bf16_t* WT, LAS float* scr, int item, int lane, const float* gk = nullptr) {
    const int nblk = N / 32, kb = item / nblk, nb = item % nblk, k0 = 64 * kb, n0 = 32 * nb;
    {
        const int rr = lane >> 3, cc = lane & 7;
#pragma unroll
        for (int i = 0; i < 8; ++i) { const int kk = 8 * i + rr; const float gs = (gk ? gk[k0 + kk] : 1.0f) * (MODE == 1 ? -LOG2E : (MODE == 2 ? -LN2 : 1.0f));
            scr[kk * 33 + 4 * cc + 0] = v[i].x * gs; scr[kk * 33 + 4 * cc + 1] = v[i].y * gs; scr[kk * 33 + 4 * cc + 2] = v[i].z * gs; scr[kk * 33 + 4 * cc + 3] = v[i].w * gs; }
    }
    asm volatile("s_waitcnt lgkmcnt(0)" ::: "memory");
    const int c = lane & 7;
#pragma unroll
    for (int j = 0; j < 4; ++j) { const int n = (lane >> 3) + 8 * j; const LAS float* s = scr + (8 * c) * 33 + n;
        u32x4 o; o.x = cvt_pk_bf16(s[0 * 33], s[1 * 33]); o.y = cvt_pk_bf16(s[2 * 33], s[3 * 33]); o.z = cvt_pk_bf16(s[4 * 33], s[5 * 33]); o.w = cvt_pk_bf16(s[6 * 33], s[7 * 33]);
        if (MODE == 3) { *(u32x4*)(WT + (size_t)(n0 + n) * K + k0 + 8 * c) = o; }
        else {
            int pn, w, h;
            if (MODE == 0) { pn = n0 >> 8; w = (n0 >> 6) & 3; h = (n0 >> 5) & 1; }
            else { pn = n0 >> 7; w = (n0 >> 5) & 3; h = MODE - 1; }
            const int R = 32 * w + 16 * ((n >> 2) & 1) + ((n >> 3) << 2) + (n & 3);
            unsigned char* img = (unsigned char*)WT + ((size_t)(pn * 2 + h) * (K / 64) + kb) * 16384;
            *(u32x4*)(img + pg8::lds_byte(R, 8 * c)) = o;
        }
    }
    asm volatile("s_waitcnt lgkmcnt(0)" ::: "memory");
}
template <int MODE>
__device__ __forceinline__ void transpose_item(const float* W, int K, int N, bf16_t* WT, LAS float* scr, int item, int lane, const float* gk = nullptr) {
    f32x4 v[8]; transpose_load(v, W, N, item, lane); transpose_finish<MODE>(v, K, N, WT, scr, item, lane, gk);
}
__device__ __forceinline__ const float* xrow_ptr(const float* xp, const float* xs, int m) { return m < MP ? xp + (size_t)m * DM : xs + (size_t)(m - MP) * DM; }

__device__ __forceinline__ int team_row(int t, int r) { return r < MP / 2 ? t * (MP / 2) + r : MP + (r - MP / 2); }
__device__ __forceinline__ int team_panel(int t, int p) { return p < 128 ? t * 128 + p : 256 + t; }

template <int PART>
__device__ __forceinline__ void p0_weights(ArgP ap, LAS unsigned char* lds, int tid, int wave, int lane, int gw, int NGW) {
    unsigned char* ws = ap->ws;
    LAS float* scr = (LAS float*)(lds + wave * 16384);
    constexpr int I_IN = 16 * 80, I_OUT = 16 * 32, I_G = 16 * 88, I_D = 44 * 32, I_P = 8;
    if (PART == 0) {
        constexpr int NITEMS = I_IN + I_OUT + 4 * I_P;
        for (int it = gw; it < NITEMS; it += NGW) {
            int r = it;
            if (r < I_IN) { transpose_item<0>(ap->in[I_WIN], DM, DIN, (bf16_t*)(ws + WS_WIN), scr, r, lane); continue; } r -= I_IN;
            if (r < I_OUT) { transpose_item<0>(ap->in[I_WOUT], DM, DM, (bf16_t*)(ws + WS_WOUT), scr, r, lane); continue; } r -= I_OUT;
            { const int g = r / I_P; transpose_item<3>(ap->in[I_WPOOL] + g * 16384, 128, 128, (bf16_t*)(ws + WS_WP) + g * 16384, scr, r % I_P, lane); }
        }
        if (blockIdx.x == 0) {
            const float l0 = ap->in[I_LBL][tid], l1 = ap->in[I_LBL][512 + tid];
            ((float*)(ws + WS_LB))[tid] = frcp(1.0f + fexp2((l1 - l0) * LOG2E));
        }
    } else {
        constexpr int NITEMS = 2 * I_G + I_D;
#define FW_LOAD(v, it_) do { int r = (it_); if (r < I_G) transpose_load(v, ap->in[I_WG], DFF, r, lane); else if (r < 2 * I_G) transpose_load(v, ap->in[I_WU], DFF, r - I_G, lane); else transpose_load(v, ap->in[I_WD], DM, r - 2 * I_G, lane); } while (0)
#define FW_FIN(v, it_) do { int r = (it_); if (r < I_G) transpose_finish<1>(v, DM, DFF, (bf16_t*)(ws + WS_WGU), scr, r, lane, ap->in[I_GPFFN]); \
            else if (r < 2 * I_G) transpose_finish<2>(v, DM, DFF, (bf16_t*)(ws + WS_WGU), scr, r - I_G, lane, ap->in[I_GPFFN]); \
            else transpose_finish<0>(v, DFF, DM, (bf16_t*)(ws + WS_WD), scr, r - 2 * I_G, lane); } while (0)
        f32x4 va[8], vb[8];
        int it = gw;
        if (it < NITEMS) FW_LOAD(va, it);
        for (; it < NITEMS; it += 2 * NGW) {
            const bool hb = it + NGW < NITEMS;
            if (hb) FW_LOAD(vb, it + NGW);
            FW_FIN(va, it);
            if (hb) { if (it + 2 * NGW < NITEMS) FW_LOAD(va, it + 2 * NGW); FW_FIN(vb, it + NGW); }
        }
#undef FW_LOAD
#undef FW_FIN
    }
}
constexpr int RW = 4;
static_assert(TROWS % RW == 0 && (MP / 2) % RW == 0, "rows per wave step");
__device__ __forceinline__ void p0_xn(ArgP ap, int t, int gw, int NGW, int lane) {
    unsigned char* tw = ap->ws + WS_TEAM + (size_t)t * TEAM_BYTES;
    bf16_t* XB = (bf16_t*)(tw + T_XB); float* RS0 = (float*)(tw + T_RS0);
    const float* xp = ap->in[I_XP]; const float* xs = ap->in[I_XS];
    f32x4 gv[4];
#pragma unroll
    for (int j = 0; j < 4; ++j) gv[j] = ((const f32x4*)ap->in[I_GPRE] + lane)[64 * j];
    for (int r0 = gw * RW; r0 < trows_of(t); r0 += NGW * RW) {
        f32x4 v[RW][4];
#pragma unroll
        for (int i = 0; i < RW; ++i) { const f32x4* xr = (const f32x4*)xrow_ptr(xp, xs, team_row(t, r0 + i)) + lane;
#pragma unroll
            for (int j = 0; j < 4; ++j) v[i][j] = xr[64 * j]; }
#pragma unroll
        for (int i = 0; i < RW; ++i) { float s = 0.f;
#pragma unroll
            for (int j = 0; j < 4; ++j) s += (v[i][j].x * v[i][j].x + v[i][j].y * v[i][j].y) + (v[i][j].z * v[i][j].z + v[i][j].w * v[i][j].w);
            const float rs = 1.0f / sqrtf(wave_sum(s) * (1.0f / DM) + EPS);
            if (lane == 0) RS0[r0 + i] = rs;
            u32x2* o8 = (u32x2*)(XB + (size_t)(r0 + i) * DM) + lane;
#pragma unroll
            for (int j = 0; j < 4; ++j) { u32x2 w; w.x = cvt_pk_bf16(v[i][j].x * rs * gv[j].x, v[i][j].y * rs * gv[j].y); w.y = cvt_pk_bf16(v[i][j].z * rs * gv[j].z, v[i][j].w * rs * gv[j].w); o8[64 * j] = w; } }
    }
}
__device__ __forceinline__ float sum16(float v) { v += __shfl_xor(v, 1); v += __shfl_xor(v, 2); v += __shfl_xor(v, 4); v += __shfl_xor(v, 8); return v; }

constexpr int H_QT = 0;
constexpr int H_KT = 17408;
constexpr int H_KD = 34816;
constexpr int H_VT = 53248;
constexpr int H_AM = 71680;
constexpr int H_PART = 80896;
constexpr int H_DEC = 84992;
constexpr int H_EBR = 85504;
constexpr int H_SSQ = 86016;
constexpr int H_DECS = 90112;
constexpr int H_GT = 90112 + 7 * 512;
constexpr int H_YT = H_GT + 64 * 272;
constexpr int H_GHG = H_YT + 64 * 272;
constexpr int H_END = H_GHG + 512;
static_assert(H_END <= 131072, "hgrn lds");
#define LDS_BAR() do { asm volatile("s_waitcnt lgkmcnt(0)" ::: "memory"); __builtin_amdgcn_s_barrier(); asm volatile("" ::: "memory"); } while (0)

struct HgrnIO {
    const unsigned* Q; const unsigned* V; const unsigned* SG;
    const unsigned* LOGF;
    bf16_t* YCAT; const float* ghg;
};
enum { HM_LOCAL = 0, HM_SAMPLE = 2, HM_FINAL = 3 };
struct HRaw { unsigned lf[8], qq[8], vv[8]; };
template <int MODE, int NTOK>
__device__ __forceinline__ void hg_load(HRaw& R, const HgrnIO& io, int crow, int h, int wave, int cp) {
    constexpr bool FULL = (MODE == HM_SAMPLE || MODE == HM_FINAL);
    const int hoff = h * 64 + cp;
    if (NTOK == 64 || wave < NTOK / 8) {
#pragma unroll
        for (int j = 0; j < 8; ++j) { const size_t r = (size_t)(crow + 8 * wave + j);
            R.lf[j] = io.LOGF[r * 256 + hoff]; R.vv[j] = io.V[r * 256 + hoff]; R.qq[j] = FULL ? io.Q[r * 256 + hoff] : 0u; }
    } else {
#pragma unroll
        for (int j = 0; j < 8; ++j) { R.lf[j] = 0u; R.vv[j] = 0u; R.qq[j] = 0u; }
    }
}
template <int NTOK>
__device__ __forceinline__ void hg_epi(LAS unsigned char* lds, int par, const f32x4 (&acc)[4], int wave, int fr, int g4) {
    LAS float* SSQ = (LAS float*)(lds + H_SSQ); LAS bf16_t* YT = (LAS bf16_t*)(lds + H_YT); const LAS bf16_t* GT = (const LAS bf16_t*)(lds + H_GT);
    f32x4 a0[4], a1[4]; u32x2 sg[4];
    const f32x4 ghv = *(const LAS f32x4*)(lds + H_GHG + (16 * wave + 4 * g4) * 4);
#pragma unroll
    for (int ti = 0; ti < 4; ++ti) { const int t = 16 * ti + fr;
        a0[ti] = *(const LAS f32x4*)(SSQ + par * 512 + t * 8); a1[ti] = *(const LAS f32x4*)(SSQ + par * 512 + t * 8 + 4);
        sg[ti] = *(const LAS u32x2*)(GT + t * 136 + 16 * wave + 4 * g4); }
    __builtin_amdgcn_sched_barrier(0);
#pragma unroll
    for (int ti = 0; ti < 4; ++ti) { const int t = 16 * ti + fr;
        const float rs = __builtin_amdgcn_rsqf(((a0[ti][0] + a0[ti][1]) + (a0[ti][2] + a0[ti][3]) + (a1[ti][0] + a1[ti][1]) + (a1[ti][2] + a1[ti][3])) * (1.0f / 128.0f) + EPS);
        const float y0 = acc[ti][0] * rs * ghv[0] * bf_lo(sg[ti].x), y1 = acc[ti][1] * rs * ghv[1] * bf_hi(sg[ti].x);
        const float y2 = acc[ti][2] * rs * ghv[2] * bf_lo(sg[ti].y), y3 = acc[ti][3] * rs * ghv[3] * bf_hi(sg[ti].y);
        u32x2 w_; w_.x = cvt_pk_bf16(y0, y1); w_.y = cvt_pk_bf16(y2, y3);
        *(LAS u32x2*)(YT + t * 136 + 16 * wave + 4 * g4) = w_; }
}
template <int NTOK>
__device__ __forceinline__ void hg_flush(LAS unsigned char* lds, const HgrnIO& io, int crow, int h, int wave, int lane) {
    LAS bf16_t* YT = (LAS bf16_t*)(lds + H_YT);
#pragma unroll
    for (int p = 0; p < 2; ++p) { const int t = 8 * wave + 4 * p + (lane >> 4), ch = lane & 15;
        const u32x4 o = *(const LAS u32x4*)(YT + t * 136 + 8 * ch);
        if (NTOK == 64 || t < NTOK) *(u32x4*)(io.YCAT + (size_t)(crow + t) * DM + 512 + h * 128 + 8 * ch) = o; }
}
__device__ __forceinline__ void hg_prefix(LAS unsigned char* lds, const HRaw& R, int wave, int cp) {
    f32x2 t = unpk_f16(R.lf[0]);
#pragma unroll
    for (int j = 1; j < 8; ++j) t += unpk_f16(R.lf[j]);
    *(LAS f32x2*)((LAS float*)(lds + H_PART) + wave * 128 + 2 * cp) = t;
}
template <int MODE>
__device__ __forceinline__ void hg_estage(LAS unsigned char* lds, const HRaw& R, float (&ldacc)[2], int wave, int cp) {
    constexpr bool FULL = (MODE == HM_SAMPLE || MODE == HM_FINAL);
    LAS bf16_t* QT = (LAS bf16_t*)(lds + H_QT); LAS bf16_t* KT = (LAS bf16_t*)(lds + H_KT); LAS bf16_t* KD = (LAS bf16_t*)(lds + H_KD); LAS bf16_t* VT = (LAS bf16_t*)(lds + H_VT);
    LAS float* PART = (LAS float*)(lds + H_PART); LAS float* DEC = (LAS float*)(lds + H_DEC); LAS float* EBR = (LAS float*)(lds + H_EBR);
    f32x2 off = (f32x2){0.f, 0.f}, bref = off, blast = off, own = off;
#pragma unroll
    for (int w2 = 0; w2 < 8; ++w2) { const f32x2 t = *(const LAS f32x2*)(PART + w2 * 128 + 2 * cp); if (w2 < wave) off += t; if (w2 == wave) own = t; if (w2 < 4) bref += t; blast += t; }
    const f32x2 edl = (f32x2){fexp2(blast.x - bref.x), fexp2(blast.y - bref.y)};
    f32x2 fj[8]; float kt0[8], kt1[8];
    f32x2 r = (f32x2){fexp2(bref.x - off.x - own.x), fexp2(bref.y - off.y - own.y)};
#pragma unroll
    for (int j = 7; j >= 0; --j) { const f32x2 lfj = unpk_f16(R.lf[j]); fj[j] = (f32x2){fexp2(lfj.x), fexp2(lfj.y)};
        kt0[j] = (1.0f - fj[j].x) * r.x; kt1[j] = (1.0f - fj[j].y) * r.y;
        r *= fj[j]; }
    unsigned kd0[4], kd1[4], v0[4], v1[4];
    float kdp0 = 0.f, kdp1 = 0.f; unsigned vlo = 0u;
    f32x2 e = (f32x2){fexp2(off.x - bref.x), fexp2(off.y - bref.y)};
#pragma unroll
    for (int j = 0; j < 8; ++j) {
        const float k0 = kt0[j], k1 = kt1[j];
        const int t = 8 * wave + j;
        if (FULL) {
            e *= fj[j];
            *(LAS unsigned*)(QT + t * 136 + 2 * cp) = cvt_pk_bf16(bf_lo(R.qq[j]) * e.x, bf_hi(R.qq[j]) * e.y);
            *(LAS unsigned*)(KT + t * 136 + 2 * cp) = cvt_pk_bf16(k0, k1);
        }
        const float d0 = k0 * edl.x, d1 = k1 * edl.y;
        if (j & 1) { kd0[j >> 1] = cvt_pk_bf16(kdp0, d0); kd1[j >> 1] = cvt_pk_bf16(kdp1, d1); v0[j >> 1] = (vlo & 0xffffu) | (R.vv[j] << 16); v1[j >> 1] = (vlo >> 16) | (R.vv[j] & 0xffff0000u); }
        else { kdp0 = d0; kdp1 = d1; vlo = R.vv[j]; }
    }
    *(LAS u32x4*)(KD + (2 * cp) * 72 + 8 * wave) = (u32x4){kd0[0], kd0[1], kd0[2], kd0[3]};
    *(LAS u32x4*)(KD + (2 * cp + 1) * 72 + 8 * wave) = (u32x4){kd1[0], kd1[1], kd1[2], kd1[3]};
    *(LAS u32x4*)(VT + (2 * cp) * 72 + 8 * wave) = (u32x4){v0[0], v0[1], v0[2], v0[3]};
    *(LAS u32x4*)(VT + (2 * cp + 1) * 72 + 8 * wave) = (u32x4){v1[0], v1[1], v1[2], v1[3]};
    if (wave == 0) { *(LAS f32x2*)(DEC + 2 * cp) = (f32x2){fexp2(blast.x), fexp2(blast.y)}; if (FULL) *(LAS f32x2*)(EBR + 2 * cp) = (f32x2){fexp2(bref.x), fexp2(bref.y)}; ldacc[0] += blast.x; ldacc[1] += blast.y; }
}
template <int MODE>
__device__ __forceinline__ void hg_stepA(LAS unsigned char* lds, f32x4 (&S)[8], f32x4 (&accO)[4], bf16x8 (&vf)[2], int wave, int fr, int g4) {
    constexpr bool FULL = (MODE == HM_SAMPLE || MODE == HM_FINAL);
    LAS bf16_t* QT = (LAS bf16_t*)(lds + H_QT); LAS bf16_t* KT = (LAS bf16_t*)(lds + H_KT); LAS bf16_t* KD = (LAS bf16_t*)(lds + H_KD);
    LAS bf16_t* VT = (LAS bf16_t*)(lds + H_VT); LAS bf16_t* AM = (LAS bf16_t*)(lds + H_AM);
    LAS float* DEC = (LAS float*)(lds + H_DEC); LAS float* EBR = (LAS float*)(lds + H_EBR);
    if (FULL) {
#pragma unroll
        for (int rep = 0; rep < 2; ++rep) {
            const int idx = wave + 8 * rep;
            if (idx < 10) {
                const int ti = idx >= 6 ? 3 : (idx >= 3 ? 2 : (idx >= 1 ? 1 : 0)), sj = idx - ti * (ti + 1) / 2;
                f32x4 a4 = (f32x4){0.f, 0.f, 0.f, 0.f}, a5 = a4;
                bf16x8 af[4], bfr[4];
#pragma unroll
                for (int ks = 0; ks < 4; ++ks) { af[ks] = *(const LAS bf16x8*)(QT + (16 * ti + fr) * 136 + 32 * ks + 8 * g4); bfr[ks] = *(const LAS bf16x8*)(KT + (16 * sj + fr) * 136 + 32 * ks + 8 * g4); }
                __builtin_amdgcn_sched_barrier(0);
                a4 = __builtin_amdgcn_mfma_f32_16x16x32_bf16(af[0], bfr[0], a4, 0, 0, 0); a5 = __builtin_amdgcn_mfma_f32_16x16x32_bf16(af[1], bfr[1], a5, 0, 0, 0);
                a4 = __builtin_amdgcn_mfma_f32_16x16x32_bf16(af[2], bfr[2], a4, 0, 0, 0); a5 = __builtin_amdgcn_mfma_f32_16x16x32_bf16(af[3], bfr[3], a5, 0, 0, 0);
                a4 += a5;
                const int s = 16 * sj + fr;
#pragma unroll
                for (int r = 0; r < 4; ++r) { const int t = 16 * ti + 4 * g4 + r; const float v = (s <= t) ? a4[r] : 0.f; AM[t * 72 + s] = (bf16_t)(cvt_pk_bf16(v, 0.f) & 0xffffu); }
            }
        }
    }
#pragma unroll
    for (int ks = 0; ks < 2; ++ks) vf[ks] = *(const LAS bf16x8*)(VT + (16 * wave + fr) * 72 + 32 * ks + 8 * g4);
    f32x4 eb[4][2]; u32x2 qv[4][4][2];
    f32x4 dvv[4][2]; bf16x8 kf[4][2][2];
#define HG_LOADQ(ks) do { eb[ks][0] = *(const LAS f32x4*)(EBR + 32 * (ks) + 4 * g4); eb[ks][1] = *(const LAS f32x4*)(EBR + 32 * (ks) + 16 + 4 * g4); \
        _Pragma("unroll") for (int ti = 0; ti < 4; ++ti) { qv[ks][ti][0] = *(const LAS u32x2*)(QT + (16 * ti + fr) * 136 + 32 * (ks) + 4 * g4); qv[ks][ti][1] = *(const LAS u32x2*)(QT + (16 * ti + fr) * 136 + 32 * (ks) + 16 + 4 * g4); } } while (0)
#define HG_COMPQ(ks) do { const f32x4 s0 = S[2 * (ks)] * eb[ks][0], s1 = S[2 * (ks) + 1] * eb[ks][1]; \
        u32x4 sw; sw.x = cvt_pk_bf16(s0[0], s0[1]); sw.y = cvt_pk_bf16(s0[2], s0[3]); sw.z = cvt_pk_bf16(s1[0], s1[1]); sw.w = cvt_pk_bf16(s1[2], s1[3]); \
        const bf16x8 sa = __builtin_bit_cast(bf16x8, sw); \
        _Pragma("unroll") for (int ti = 0; ti < 4; ++ti) { const bf16x8 qf = __builtin_bit_cast(bf16x8, ((u32x4){qv[ks][ti][0].x, qv[ks][ti][0].y, qv[ks][ti][1].x, qv[ks][ti][1].y})); \
            accO[ti] = __builtin_amdgcn_mfma_f32_16x16x32_bf16(sa, qf, accO[ti], 0, 0, 0); } } while (0)
#define HG_LOADK(g) do { _Pragma("unroll") for (int q = 0; q < 2; ++q) { dvv[g][q] = *(const LAS f32x4*)(DEC + 16 * (2 * (g) + q) + 4 * g4); \
        _Pragma("unroll") for (int ks = 0; ks < 2; ++ks) kf[g][q][ks] = *(const LAS bf16x8*)(KD + (16 * (2 * (g) + q) + fr) * 72 + 32 * ks + 8 * g4); } } while (0)
#define HG_COMPK(g) do { _Pragma("unroll") for (int q = 0; q < 2; ++q) { S[2 * (g) + q] = S[2 * (g) + q] * dvv[g][q]; \
        _Pragma("unroll") for (int ks = 0; ks < 2; ++ks) S[2 * (g) + q] = __builtin_amdgcn_mfma_f32_16x16x32_bf16(kf[g][q][ks], vf[ks], S[2 * (g) + q], 0, 0, 0); } } while (0)
#define HG_SB() __builtin_amdgcn_sched_barrier(0)
    if (FULL) {
#pragma unroll
        for (int ti = 0; ti < 4; ++ti) accO[ti] = (f32x4){0.f, 0.f, 0.f, 0.f};
        HG_LOADQ(0); HG_LOADQ(1); HG_SB();
        HG_COMPQ(0); HG_SB(); HG_LOADQ(2); HG_SB();
        HG_COMPQ(1); HG_SB(); HG_LOADQ(3); HG_SB();
        HG_COMPQ(2); HG_SB(); HG_LOADK(0); HG_SB();
        HG_COMPQ(3); HG_SB(); HG_LOADK(1); HG_SB();
    } else { HG_LOADK(0); HG_LOADK(1); HG_SB(); }
    HG_COMPK(0); HG_SB(); HG_LOADK(2); HG_SB();
    HG_COMPK(1); HG_SB(); HG_LOADK(3); HG_SB();
    HG_COMPK(2); HG_COMPK(3);
#undef HG_LOADQ
#undef HG_COMPQ
#undef HG_LOADK
#undef HG_COMPK
#undef HG_SB
}
__device__ __forceinline__ void hg_stepB(LAS unsigned char* lds, f32x4 (&accO)[4], const bf16x8 (&vf)[2], int par, int wave, int fr, int g4) {
    LAS bf16_t* AM = (LAS bf16_t*)(lds + H_AM); LAS float* SSQ = (LAS float*)(lds + H_SSQ);
    bf16x8 bfr[4][2];
#pragma unroll
    for (int ti = 0; ti < 4; ++ti)
#pragma unroll
        for (int ks = 0; ks < 2; ++ks) { if (ks == 1 && ti < 2) continue; bfr[ti][ks] = *(const LAS bf16x8*)(AM + (16 * ti + fr) * 72 + 32 * ks + 8 * g4); }
    __builtin_amdgcn_sched_barrier(0);
#pragma unroll
    for (int ks = 0; ks < 2; ++ks)
#pragma unroll
        for (int ti = 0; ti < 4; ++ti) { if (ks == 1 && ti < 2) continue; accO[ti] = __builtin_amdgcn_mfma_f32_16x16x32_bf16(vf[ks], bfr[ti][ks], accO[ti], 0, 0, 0); }
    float pz[4];
#pragma unroll
    for (int ti = 0; ti < 4; ++ti) pz[ti] = (accO[ti][0] * accO[ti][0] + accO[ti][1] * accO[ti][1]) + (accO[ti][2] * accO[ti][2] + accO[ti][3] * accO[ti][3]);
    const bool hi2 = (g4 & 2) != 0, hi1 = (g4 & 1) != 0;
    const float k0 = hi2 ? pz[2] : pz[0], k1 = hi2 ? pz[3] : pz[1], s0 = hi2 ? pz[0] : pz[2], s1 = hi2 ? pz[1] : pz[3];
    const float r0 = __shfl_xor(s0, 32), r1 = __shfl_xor(s1, 32);
    const float u0 = k0 + r0, u1 = k1 + r1;
    const float keep = hi1 ? u1 : u0, send = hi1 ? u0 : u1;
    const float tot = keep + __shfl_xor(send, 16);
    SSQ[par * 512 + (16 * g4 + fr) * 8 + wave] = tot;
}
template <int NTOK>
__device__ __forceinline__ void hg_gates_load(u32x4 (&gr)[2], const HgrnIO& io, int crow, int h, int wave, int lane) {
#pragma unroll
    for (int p = 0; p < 2; ++p) { const int t = 8 * wave + 4 * p + (lane >> 4), ch = lane & 15;
        gr[p] = (NTOK == 64 || t < NTOK) ? *(const u32x4*)(io.SG + (size_t)(crow + t) * 256 + h * 64 + 4 * ch) : (u32x4){0u, 0u, 0u, 0u}; }
}
__device__ __forceinline__ void hg_gates_put(LAS unsigned char* lds, const u32x4 (&gr)[2], int wave, int lane) {
#pragma unroll
    for (int p = 0; p < 2; ++p) { const int t = 8 * wave + 4 * p + (lane >> 4), ch = lane & 15; *(LAS u32x4*)((LAS bf16_t*)(lds + H_GT) + t * 136 + 8 * ch) = gr[p]; }
}
template <int MODE, int NTOK>
__device__ __forceinline__ void hg_step(LAS unsigned char* lds, const HgrnIO& io, HRaw& Rn, int c, int nch, int row0, int h, f32x4 (&S)[8], float (&ldacc)[2],
                                        f32x4 (&accP)[4], int wave, int lane) {
    constexpr bool FULL = (MODE == HM_SAMPLE || MODE == HM_FINAL);
    const int cp = lane, fr = lane & 15, g4 = lane >> 4, crow = row0 + 64 * c, par = c & 1;
    const bool more = c + 1 < nch;
    bf16x8 vf[2]; u32x4 gr[2];
    if (FULL) {
        if (c > 0) hg_epi<NTOK>(lds, par ^ 1, accP, wave, fr, g4);
        hg_gates_load<NTOK>(gr, io, crow, h, wave, lane);
    }
    hg_stepA<MODE>(lds, S, accP, vf, wave, fr, g4);
    if (more) hg_prefix(lds, Rn, wave, cp);
    LDS_BAR();
    if (FULL) { if (c > 0) hg_flush<NTOK>(lds, io, crow - 64, h, wave, lane); hg_stepB(lds, accP, vf, par, wave, fr, g4); hg_gates_put(lds, gr, wave, lane); }
    if (more) {
        hg_estage<MODE>(lds, Rn, ldacc, wave, cp);
        if (c + 3 < nch) hg_load<MODE, NTOK>(Rn, io, crow + 192, h, wave, cp);
    }
    LDS_BAR();
}
template <int MODE, int NTOK>
__device__ __forceinline__ void hgrn_chunks(LAS unsigned char* lds, const HgrnIO& io, int row0, int nch, int h, f32x4 (&S)[8], float (&ldacc)[2], int tid, int wave, int lane) {
    constexpr bool FULL = (MODE == HM_SAMPLE || MODE == HM_FINAL);
    const int fr = lane & 15, g4 = lane >> 4;
    if (FULL) {
        if (tid < 128) ((LAS float*)(lds + H_GHG))[tid] = io.ghg[tid];
        for (int i = tid; i < 9216 / 4; i += 512) ((LAS unsigned*)(lds + H_AM))[i] = 0u;
    }
    HRaw RA, RB;
    hg_load<MODE, NTOK>(RA, io, row0, h, wave, lane);
    if (nch > 1) hg_load<MODE, NTOK>(RB, io, row0 + 64, h, wave, lane);
    f32x4 accP[4];
#pragma unroll
    for (int ti = 0; ti < 4; ++ti) accP[ti] = (f32x4){0.f, 0.f, 0.f, 0.f};
    { hg_prefix(lds, RA, wave, lane); LDS_BAR(); hg_estage<MODE>(lds, RA, ldacc, wave, lane); if (nch > 2) hg_load<MODE, NTOK>(RA, io, row0 + 128, h, wave, lane); LDS_BAR(); }
    for (int c = 0; c < nch; c += 2) {
        hg_step<MODE, NTOK>(lds, io, RB, c, nch, row0, h, S, ldacc, accP, wave, lane);
        if (c + 1 < nch) hg_step<MODE, NTOK>(lds, io, RA, c + 1, nch, row0, h, S, ldacc, accP, wave, lane);
    }
    if (FULL) { hg_epi<NTOK>(lds, (nch - 1) & 1, accP, wave, fr, g4); LDS_BAR(); hg_flush<NTOK>(lds, io, row0 + 64 * (nch - 1), h, wave, lane); }
    LDS_BAR();
}

constexpr int L_KD = 0;
constexpr int L_VT = 34816;
static_assert(L_VT + 34816 <= H_PART, "local128 lds");
struct HRawL { unsigned lf[16], vv[16]; };
__device__ __forceinline__ void hl_load(HRawL& R, const HgrnIO& io, int crow, int h, int wave, int cp) {
    const int hoff = h * 64 + cp;
#pragma unroll
    for (int j = 0; j < 16; ++j) { const size_t r = (size_t)(crow + 16 * wave + j); R.lf[j] = io.LOGF[r * 256 + hoff]; R.vv[j] = io.V[r * 256 + hoff]; }
}
__device__ __forceinline__ void hl_prefix(LAS unsigned char* lds, const HRawL& R, int wave, int cp) {
    f32x2 t = unpk_f16(R.lf[0]);
#pragma unroll
    for (int j = 1; j < 16; ++j) t += unpk_f16(R.lf[j]);
    *(LAS f32x2*)((LAS float*)(lds + H_PART) + wave * 128 + 2 * cp) = t;
}
__device__ __forceinline__ void hl_estage(LAS unsigned char* lds, const HRawL& R, float (&ldacc)[2], int wave, int cp) {
    LAS bf16_t* KD = (LAS bf16_t*)(lds + L_KD); LAS bf16_t* VT = (LAS bf16_t*)(lds + L_VT);
    LAS float* PART = (LAS float*)(lds + H_PART); LAS float* DEC = (LAS float*)(lds + H_DEC);
    f32x2 off = (f32x2){0.f, 0.f}, blast = off, own = off;
#pragma unroll
    for (int w2 = 0; w2 < 8; ++w2) { const f32x2 t = *(const LAS f32x2*)(PART + w2 * 128 + 2 * cp); if (w2 < wave) off += t; if (w2 == wave) own = t; blast += t; }
    unsigned kd0[8], kd1[8], v0[8], v1[8];
    float kp0 = 0.f, kp1 = 0.f; unsigned vhi = 0u;
    f32x2 r = (f32x2){fexp2(blast.x - off.x - own.x), fexp2(blast.y - off.y - own.y)};
#pragma unroll
    for (int j = 15; j >= 0; --j) {
        const f32x2 lfj = unpk_f16(R.lf[j]); const f32x2 f = (f32x2){fexp2(lfj.x), fexp2(lfj.y)};
        const float d0 = (1.0f - f.x) * r.x, d1 = (1.0f - f.y) * r.y;
        r *= f;
        if (j & 1) { kp0 = d0; kp1 = d1; vhi = R.vv[j]; }
        else { kd0[j >> 1] = cvt_pk_bf16(d0, kp0); kd1[j >> 1] = cvt_pk_bf16(d1, kp1); v0[j >> 1] = (R.vv[j] & 0xffffu) | (vhi << 16); v1[j >> 1] = (R.vv[j] >> 16) | (vhi & 0xffff0000u); }
    }
#pragma unroll
    for (int q = 0; q < 2; ++q) {
        *(LAS u32x4*)(KD + (2 * cp) * 136 + 16 * wave + 8 * q) = (u32x4){kd0[4 * q], kd0[4 * q + 1], kd0[4 * q + 2], kd0[4 * q + 3]};
        *(LAS u32x4*)(KD + (2 * cp + 1) * 136 + 16 * wave + 8 * q) = (u32x4){kd1[4 * q], kd1[4 * q + 1], kd1[4 * q + 2], kd1[4 * q + 3]};
        *(LAS u32x4*)(VT + (2 * cp) * 136 + 16 * wave + 8 * q) = (u32x4){v0[4 * q], v0[4 * q + 1], v0[4 * q + 2], v0[4 * q + 3]};
        *(LAS u32x4*)(VT + (2 * cp + 1) * 136 + 16 * wave + 8 * q) = (u32x4){v1[4 * q], v1[4 * q + 1], v1[4 * q + 2], v1[4 * q + 3]};
    }
    if (wave == 0) { *(LAS f32x2*)(DEC + 2 * cp) = (f32x2){fexp2(blast.x), fexp2(blast.y)}; ldacc[0] += blast.x; ldacc[1] += blast.y; }
}
__device__ __forceinline__ void hl_step3(LAS unsigned char* lds, f32x4 (&S)[8], int wave, int fr, int g4) {
    LAS bf16_t* KD = (LAS bf16_t*)(lds + L_KD); LAS bf16_t* VT = (LAS bf16_t*)(lds + L_VT); LAS float* DEC = (LAS float*)(lds + H_DEC);
    bf16x8 vf[4];
#pragma unroll
    for (int ks = 0; ks < 4; ++ks) vf[ks] = *(const LAS bf16x8*)(VT + (16 * wave + fr) * 136 + 32 * ks + 8 * g4);
#pragma unroll
    for (int kt = 0; kt < 8; ++kt) {
        const f32x4 dv = *(const LAS f32x4*)(DEC + 16 * kt + 4 * g4);
        S[kt] = S[kt] * dv;
#pragma unroll
        for (int ks = 0; ks < 4; ++ks) {
            const bf16x8 af = *(const LAS bf16x8*)(KD + (16 * kt + fr) * 136 + 32 * ks + 8 * g4);
            S[kt] = __builtin_amdgcn_mfma_f32_16x16x32_bf16(af, vf[ks], S[kt], 0, 0, 0);
        }
    }
}
__device__ __forceinline__ void hl_step(LAS unsigned char* lds, const HgrnIO& io, HRawL& Rn, int c, int nch, int row0, int h, f32x4 (&S)[8], float (&ldacc)[2], int wave, int lane) {
    const bool more = c + 1 < nch;
    hl_step3(lds, S, wave, lane & 15, lane >> 4);
    if (more) hl_prefix(lds, Rn, wave, lane);
    LDS_BAR();
    if (more) { hl_estage(lds, Rn, ldacc, wave, lane); if (c + 3 < nch) hl_load(Rn, io, row0 + 128 * (c + 3), h, wave, lane); }
    LDS_BAR();
}
__device__ __forceinline__ void hgrn_local128(LAS unsigned char* lds, const HgrnIO& io, int row0, int nch, int h, f32x4 (&S)[8], float (&ldacc)[2], int wave, int lane) {
    HRawL RA, RB;
    hl_load(RA, io, row0, h, wave, lane);
    hl_load(RB, io, row0 + 128, h, wave, lane);
    { hl_prefix(lds, RA, wave, lane); LDS_BAR(); hl_estage(lds, RA, ldacc, wave, lane); hl_load(RA, io, row0 + 256, h, wave, lane); LDS_BAR(); }
    for (int c = 0; c < nch; c += 2) {
        hl_step(lds, io, RB, c, nch, row0, h, S, ldacc, wave, lane);
        hl_step(lds, io, RA, c + 1, nch, row0, h, S, ldacc, wave, lane);
    }
    LDS_BAR();
}

__device__ __forceinline__ void state_load(const float* src, f32x4 (&S)[8], int wave, int lane) {
    const int fr = lane & 15, g4 = lane >> 4;
#pragma unroll
    for (int kt = 0; kt < 8; ++kt)
#pragma unroll
        for (int r = 0; r < 4; ++r) S[kt][r] = src[(16 * kt + 4 * g4 + r) * 128 + 16 * wave + fr];
}
__device__ __forceinline__ void state_store(float* dst, const f32x4 (&S)[8], int wave, int lane) {
    const int fr = lane & 15, g4 = lane >> 4;
#pragma unroll
    for (int kt = 0; kt < 8; ++kt)
#pragma unroll
        for (int r = 0; r < 4; ++r) dst[(16 * kt + 4 * g4 + r) * 128 + 16 * wave + fr] = S[kt][r];
}

constexpr int PL_WP = 0;
constexpr int PL_DT = 34816;
constexpr int PL_END = PL_DT + 256 * 272;
static_assert(PL_END <= 131072, "pool lds");
constexpr int CW_POOL = 64;
template <int W>
__device__ __forceinline__ void pool_dtile(LAS bf16_t* DT, const unsigned* U, const float* cache, float* outp, int m0, int g, int team, int wave, int lane) {
    const int cp = lane, mrow = m0 + 32 * wave;
    const bool is_s = mrow >= MP / 2;
    int pos0, seqrow0, sb = 0, bb = 0;
    if (!is_s) { pos0 = mrow & (SEQ - 1); seqrow0 = mrow - pos0; bb = team * 4 + (mrow >> 13); } else { sb = (mrow - MP / 2) >> 5; pos0 = 0; seqrow0 = mrow; }
    const int ucol = g * 64 + cp;
    f32x2 uv[47];
#pragma unroll
    for (int i = 16 - W; i < 15; ++i) {
        const int pos = pos0 - 15 + i, pc = pos < 0 ? 0 : pos;
        int ci = 15 + pos; ci = ci < 0 ? 0 : (ci > 14 ? 14 : ci);
        const unsigned w = U[(size_t)(seqrow0 + pc) * 256 + ucol];
        const f32x2 cv = *(const f32x2*)(cache + (size_t)(sb * 15 + ci) * 512 + 2 * ucol);
        f32x2 r = (f32x2){bf_lo(w), bf_hi(w)};
        if (pos < 0) r = is_s ? cv : (f32x2){0.f, 0.f};
        uv[i] = r;
    }
#pragma unroll
    for (int i = 15; i < 47; ++i) { const unsigned w = U[(size_t)(seqrow0 + pos0 + i - 15) * 256 + ucol]; uv[i] = (f32x2){bf_lo(w), bf_hi(w)}; }
    f32x2 sum = (f32x2){0.f, 0.f};
#pragma unroll
    for (int i = 16 - W; i < 15; ++i) sum += uv[i];
#pragma unroll
    for (int t = 0; t < 32; ++t) {
        const int pos = pos0 + t;
        const f32x2 u = uv[15 + t];
        sum += u;
        const int cnt = is_s ? W : (pos + 1 < W ? pos + 1 : W);
        const float ic = 1.0f / (float)cnt;
        const f32x2 d = sum * ic - u;
        sum -= uv[15 + t - W + 1];
        *(LAS unsigned*)(DT + (32 * wave + t) * 136 + 2 * cp) = cvt_pk_bf16(d.x, d.y);
        if (!is_s && pos >= SEQ - 15) *(f32x2*)(outp + OFF_PP + (size_t)(bb * 15 + pos - (SEQ - 15)) * 512 + 2 * ucol) = u;
        if (is_s && pos >= DSEQ - 15) *(f32x2*)(outp + OFF_PS + (size_t)(sb * 15 + pos - (DSEQ - 15)) * 512 + 2 * ucol) = u;
    }
}
__device__ __forceinline__ void pool_phase(LAS unsigned char* lds, ArgP ap, volatile LAS unsigned* MISC, int team, int tl, int tid, int wave, int lane) {
    unsigned char* ws = ap->ws; float* outp = ap->out;
    unsigned char* tws = ws + WS_TEAM + (size_t)team * TEAM_BYTES;
    const unsigned* U = (const unsigned*)(tws + T_U);
    const bf16_t* WPT = (const bf16_t*)(ws + WS_WP);
    bf16_t* YCAT = (bf16_t*)(tws + T_A);
    unsigned* ctl = (unsigned*)(ws + WS_CTL);
    const float* cache = ap->in[I_CACHE];
    LAS bf16_t* WP = (LAS bf16_t*)(lds + PL_WP); LAS bf16_t* DT = (LAS bf16_t*)(lds + PL_DT);
    const int fr = lane & 15, g4 = lane >> 4;
    int g = tl & 3, loaded = -1, tries = 0, slot = 0;
    unsigned nxt = 0u;
    if (tid == 0) nxt = __hip_atomic_fetch_add(ctl + CW_POOL * (1 + 4 * team + g), 1u, __ATOMIC_RELAXED, __HIP_MEMORY_SCOPE_AGENT);
    while (tries < 4) {
        if (tid == 0) MISC[4 + slot] = nxt;
        LDS_BAR();
        const int it = (int)MISC[4 + slot]; slot ^= 1;
        if (it >= 128 + nsp_of(team)) { g = (g + 1) & 3; ++tries;
            if (tid == 0 && tries < 4) nxt = __hip_atomic_fetch_add(ctl + CW_POOL * (1 + 4 * team + g), 1u, __ATOMIC_RELAXED, __HIP_MEMORY_SCOPE_AGENT);
            continue; }
        if (tid == 0) nxt = __hip_atomic_fetch_add(ctl + CW_POOL * (1 + 4 * team + g), 1u, __ATOMIC_RELAXED, __HIP_MEMORY_SCOPE_AGENT);
        if (loaded != g) {
            for (int i = tid; i < 128 * 16; i += 512) { const int r = i >> 4, c = i & 15; *(LAS u32x4*)(WP + r * 136 + 8 * c) = *(const u32x4*)(WPT + (size_t)g * 16384 + r * 128 + 8 * c); }
            loaded = g;
            __syncthreads();
        }
        const int m0 = it * 256;
        switch (g) {
            case 0: pool_dtile<2>(DT, U, cache, outp, m0, g, team, wave, lane); break;
            case 1: pool_dtile<4>(DT, U, cache, outp, m0, g, team, wave, lane); break;
            case 2: pool_dtile<8>(DT, U, cache, outp, m0, g, team, wave, lane); break;
            default: pool_dtile<16>(DT, U, cache, outp, m0, g, team, wave, lane); break;
        }
        asm volatile("s_waitcnt lgkmcnt(0)" ::: "memory");
        bf16x8 bfr[2][4];
#pragma unroll
        for (int tt = 0; tt < 2; ++tt)
#pragma unroll
            for (int ks = 0; ks < 4; ++ks) bfr[tt][ks] = *(const LAS bf16x8*)(DT + (32 * wave + 16 * tt + fr) * 136 + 32 * ks + 8 * g4);
        const float* psc = ap->in[I_PSCALE] + g * 128;
#pragma unroll 2
        for (int nb = 0; nb < 8; ++nb) {
            bf16x8 af[4];
#pragma unroll
            for (int ks = 0; ks < 4; ++ks) af[ks] = *(const LAS bf16x8*)(WP + (16 * nb + fr) * 136 + 32 * ks + 8 * g4);
            const f32x4 sc = *(const f32x4*)(psc + 16 * nb + 4 * g4);
#pragma unroll
            for (int tt = 0; tt < 2; ++tt) {
                f32x4 acc = (f32x4){0.f, 0.f, 0.f, 0.f};
#pragma unroll
                for (int ks = 0; ks < 4; ++ks) acc = __builtin_amdgcn_mfma_f32_16x16x32_bf16(af[ks], bfr[tt][ks], acc, 0, 0, 0);
                acc = acc * sc;
                u32x2 w; w.x = cvt_pk_bf16(acc[0], acc[1]); w.y = cvt_pk_bf16(acc[2], acc[3]);
                *(LAS u32x2*)(DT + (32 * wave + 16 * tt + fr) * 136 + 16 * nb + 4 * g4) = w;
            }
        }
        asm volatile("" ::: "memory");
#pragma unroll
        for (int p = 0; p < 8; ++p) { const int row = 32 * wave + 4 * p + (lane >> 4), ch = lane & 15;
            const u32x4 o = *(const LAS u32x4*)(DT + row * 136 + 8 * ch);
            *(u32x4*)(YCAT + (size_t)(m0 + row) * DM + g * 128 + 8 * ch) = o; }
        asm volatile("" ::: "memory");
    }
    __syncthreads();
}

constexpr int CW_BAR = 1024;
#define XB_TMO      128
#define XB_XCNT(j)  (256  + 64 * (j))
#define XB_XSUB(j)  (1280 + 64 * (j))
#define XB_XGEN(j)  (2304 + 64 * (j))
#define XB_TOP      3328
#define XB_TOPGEN   3392
#define XCD_BAR_WORDS 3456
#define XB_SPIN_CAP (1u << 20)
constexpr unsigned TEAM_WGS = 128;
__device__ __forceinline__ unsigned xb_ld(unsigned* p)              { return __hip_atomic_load(p, __ATOMIC_RELAXED, __HIP_MEMORY_SCOPE_AGENT); }
__device__ __forceinline__ unsigned xb_add(unsigned* p, unsigned v) { return __hip_atomic_fetch_add(p, v, __ATOMIC_RELAXED, __HIP_MEMORY_SCOPE_AGENT); }
__device__ __forceinline__ unsigned xb_xcc_id() { return (unsigned)__builtin_amdgcn_s_getreg((3 << 11) | 20) & 0xFu; }
#define XB_SPIN(cond, bar) do { unsigned _sp = 0; while (cond) { __builtin_amdgcn_s_sleep(1); \
    if ((++_sp & 255u) == 0u) { if (xb_ld(&(bar)[XB_TMO])) break; if (_sp > XB_SPIN_CAP) { atomicAdd(&(bar)[XB_TMO], 1u); break; } } } } while (0)
struct XcdBarrier { unsigned* bar; unsigned x; volatile LAS unsigned* st; unsigned G; };
__device__ __forceinline__ XcdBarrier xcd_barrier_post(unsigned* bar, volatile LAS unsigned* st, unsigned G) {
    XcdBarrier b; b.bar = bar; b.x = xb_xcc_id(); b.st = st; b.G = G;
    if (threadIdx.x == 0) (void)xb_add(&bar[XB_XCNT(b.x)], 1u);
    return b;
}
__device__ __forceinline__ void xcd_barrier_complete(unsigned* bar, unsigned x, unsigned G, unsigned& nloc, unsigned& nx) {
    unsigned sum, cnt, mine, sp = 0u;
    for (;;) {
        sum = 0u; cnt = 0u; mine = 0u;
#pragma unroll
        for (unsigned j = 0; j < 16; ++j) { const unsigned c = xb_ld(&bar[XB_XCNT(j)]); sum += c; cnt += (c > 0u) ? 1u : 0u; mine = (j == x) ? c : mine; }
        if (sum == G) break;
        __builtin_amdgcn_s_sleep(1);
        if ((++sp & 255u) == 0u) { if (xb_ld(&bar[XB_TMO])) break; if (sp > XB_SPIN_CAP) { atomicAdd(&bar[XB_TMO], 1u); break; } }
    }
    nloc = mine > 0u ? mine : 1u; nx = cnt > 0u ? cnt : 1u;
}
__device__ __forceinline__ void xcd_barrier(const XcdBarrier& b) {
    asm volatile("s_waitcnt vmcnt(0)" ::: "memory");
    __syncthreads();
    if (threadIdx.x == 0) {
        unsigned* bar = b.bar;
        __builtin_amdgcn_s_waitcnt(0);
        unsigned nloc = b.st[0], nx = b.st[1];
        if (nloc == 0u) { xcd_barrier_complete(bar, b.x, b.G, nloc, nx); b.st[0] = nloc; b.st[1] = nx; }
        const unsigned old = xb_add(&bar[XB_XSUB(b.x)], 1u);
        const unsigned gen = old / nloc;
        if (old + 1u == (gen + 1u) * nloc) {
            __builtin_amdgcn_fence(__ATOMIC_RELEASE, "agent");
            asm volatile("s_waitcnt vmcnt(0)" ::: "memory");
            const unsigned og = xb_add(&bar[XB_TOP], 1u);
            const unsigned tg = og / nx;
            if (og + 1u == (tg + 1u) * nx) xb_add(&bar[XB_TOPGEN], 1u);
            else XB_SPIN(xb_ld(&bar[XB_TOPGEN]) == tg, bar);
            __builtin_amdgcn_fence(__ATOMIC_ACQUIRE, "agent");
            xb_add(&bar[XB_XGEN(b.x)], 1u);
            asm volatile("s_waitcnt vmcnt(0)" ::: "memory");
        } else {
            XB_SPIN(xb_ld(&bar[XB_XGEN(b.x)]) == gen, bar);
            __builtin_amdgcn_fence(__ATOMIC_ACQUIRE, "agent");
            asm volatile("s_waitcnt vmcnt(0)" ::: "memory");
        }
    }
    __syncthreads();
}
constexpr int MISC_OFF = 131072;

constexpr int CW_ROWQ = 12288, CW_FLAG = 12288 + 512, CW_WFLAG = CW_FLAG + 128;
constexpr int P1_TAIL_UNITS = (128 + 2) * (DIN / 256) - 10 * 128;
static_assert(P1_TAIL_UNITS == 20 && CW_WFLAG * 4 + 4 <= (int)CTL_ZERO_BYTES, "P1 tail");
#define ROWQ_BEGIN(qw) { int _slot = 0; unsigned _nxt = 0u; if (tid == 0) MISC[10] = __hip_atomic_fetch_add((qw), 1u, __ATOMIC_RELAXED, __HIP_MEMORY_SCOPE_AGENT); LDS_BAR(); int _blk = (int)MISC[10]; \
    while (_blk < (MP / 2) / 32) { if (tid == 0) _nxt = __hip_atomic_fetch_add((qw), 1u, __ATOMIC_RELAXED, __HIP_MEMORY_SCOPE_AGENT); const int r0 = _blk * 32 + wave * RW;
#define ROWQ_END() _slot ^= 1; if (tid == 0) MISC[10 + _slot] = _nxt; LDS_BAR(); _blk = (int)MISC[10 + _slot]; } }
__device__ __forceinline__ void p5b_rows(unsigned char* twb, int tt, int r0, float* outp, const f32x4 (&g3)[4], int lane) {
    const bf16_t* FB = (const bf16_t*)(twb + T_C); const bf16_t* X1 = (const bf16_t*)(twb + T_X1); const float* SS = (const float*)(twb + T_SS); const float* RS2 = (const float*)(twb + T_RS2);
    u32x2 xv[RW][4], y[RW][4]; float ssp[RW], r2v[RW];
    { const f32x4 sv = *(const f32x4*)(SS + (size_t)(r0 >> 4) * 256 + (lane & 15) * 16 + (r0 & 15)); ssp[0] = sv[0]; ssp[1] = sv[1]; ssp[2] = sv[2]; ssp[3] = sv[3]; }
#pragma unroll
    for (int i = 0; i < RW; ++i) { const int r = r0 + i; const u32x2* xr = (const u32x2*)(X1 + (size_t)r * DM) + lane; const u32x2* fr_ = (const u32x2*)(FB + (size_t)r * DM) + lane;
        r2v[i] = RS2[r];
#pragma unroll
        for (int j = 0; j < 4; ++j) { xv[i][j] = xr[64 * j]; y[i][j] = fr_[64 * j]; } }
#pragma unroll
    for (int i = 0; i < RW; ++i) { const int r = r0 + i;
        const float rs3 = 1.0f / sqrtf(sum16(ssp[i]) * (1.0f / DM) + EPS), ir2 = 1.0f / r2v[i];
        f32x4* orow = (f32x4*)(outp + OFF_Y + (size_t)team_row(tt, r) * DM) + lane;
#pragma unroll
        for (int j = 0; j < 4; ++j) { const u32x2 xx = xv[i][j], yy = y[i][j]; f32x4 x;
            x.x = bf_lo(xx.x) * ir2 + bf_lo(yy.x) * rs3 * g3[j].x; x.y = bf_hi(xx.x) * ir2 + bf_hi(yy.x) * rs3 * g3[j].y; x.z = bf_lo(xx.y) * ir2 + bf_lo(yy.y) * rs3 * g3[j].z; x.w = bf_hi(xx.y) * ir2 + bf_hi(yy.y) * rs3 * g3[j].w;
            orow[64 * j] = x; } }
}
#define PHASE_BEGIN() ArgP ap = get_args(); unsigned char* ws = ap->ws; unsigned char* tws = ws + WS_TEAM + (size_t)team * TEAM_BYTES; const int tid = opaque_tid(), lane = tid & 63, wave = __builtin_amdgcn_readfirstlane(tid >> 6); (void)lane; (void)wave; (void)ws; (void)tws
__global__ void __launch_bounds__(512, 2) fwd_megakernel(Args a_unused) {
    extern __shared__ __attribute__((aligned(16))) unsigned char lds_raw[];
    LAS unsigned char* lds = (LAS unsigned char*)lds_raw;
    cg::grid_group grid = cg::this_grid();
    const int bid = blockIdx.x;
    const int team = (bid & 7) >> 2, tl = ((bid >> 3) << 2) | (bid & 3);
    constexpr int G = 128;
    volatile LAS unsigned* MISC = (volatile LAS unsigned*)(lds + MISC_OFF);
    if (threadIdx.x < 16) MISC[threadIdx.x] = 0u;
    __syncthreads();
    const XcdBarrier bar = xcd_barrier_post((unsigned*)(get_args()->ws + WS_CTL) + CW_BAR + team * XCD_BAR_WORDS, MISC, TEAM_WGS);
    const XcdBarrier gbar = xcd_barrier_post((unsigned*)(get_args()->ws + WS_CTL) + CW_BAR + 2 * XCD_BAR_WORDS, MISC + 2, 256u);
#define TEAM_BAR() xcd_barrier(bar)

    { PHASE_BEGIN(); p0_weights<0>(ap, lds, tid, wave, lane, bid * 8 + wave, gridDim.x * 8); p0_xn(ap, 0, bid * 8 + wave, gridDim.x * 8, lane); }
    if (get_args()->ws == nullptr) grid.sync();
    xcd_barrier(gbar);
    if (team == 1) { { PHASE_BEGIN(); p0_xn(ap, 1, tl * 8 + wave, G * 8, lane); } TEAM_BAR(); }

    {
        PHASE_BEGIN();
        pg8::Gemm g{(const bf16_t*)(tws + T_XB), (const bf16_t*)(ws + WS_WIN), TROWS, DIN, DM}; pg8::StaticOrder<DIN / 256, 0> S; S.init(128 + nsp_of(team), DIN, DM, G, tl, 0);
        pg8::EpiZ E{tws, (const float*)(ws + WS_LB), lds + pg8::EPI_STG_OFF};
        pg8::gemm_phase<pg8::EpiZ, pg8::StaticOrder<DIN / 256, 0>, true, true>(lds, g, S, E);
        if (team == 0 && tl >= P1_TAIL_UNITS) p0_weights<1>(ap, lds, tid, wave, lane, (tl - P1_TAIL_UNITS) * 8 + wave, (G - P1_TAIL_UNITS) * 8);
    }
    TEAM_BAR();
    if (team == 0 && tl == 0 && threadIdx.x == 0) __hip_atomic_store((unsigned*)(get_args()->ws + WS_CTL) + CW_WFLAG, 1u, __ATOMIC_RELEASE, __HIP_MEMORY_SCOPE_AGENT);

    const int seq = team * 16 + (tl >> 3), seg = tl & 7;
    {
        PHASE_BEGIN();
        HgrnIO io{(const unsigned*)(tws + T_Q), (const unsigned*)(tws + T_V), (const unsigned*)(tws + T_SG), (const unsigned*)(tws + T_LOGF), (bf16_t*)(tws + T_A), ap->in[I_GHG]};
        if (seg < 7) {
            f32x4 S[8]; float ldacc[2] = {0.f, 0.f};
#pragma unroll
            for (int kt = 0; kt < 8; ++kt) S[kt] = (f32x4){0.f, 0.f, 0.f, 0.f};
            hgrn_local128(lds, io, ((seq >> 2) & 3) * SEQ + seg * 1024, 8, seq & 3, S, ldacc, wave, lane);
            float* sl = (float*)(ws + WS_SLOC) + (size_t)(seq * 8 + seg) * 16384;
#pragma unroll
            for (int kt = 0; kt < 8; ++kt) *(f32x4*)(sl + ((wave * 8 + kt) * 64 + lane) * 4) = S[kt];
            if (wave == 0) *(f32x2*)((float*)(ws + WS_LD) + (seq * 8 + seg) * 128 + 2 * lane) = (f32x2){ldacc[0], ldacc[1]};
        }
        if (team == 0 && (tl & 1) == 0) {
            const int idx = tl >> 1, sb = idx >> 2, h = idx & 3;
            f32x4 S[8]; float ldacc[2] = {0.f, 0.f};
            state_load(ap->in[I_STATE] + (size_t)idx * 16384, S, wave, lane);
            hgrn_chunks<HM_SAMPLE, 32>(lds, io, MP / 2 + sb * DSEQ, 1, h, S, ldacc, tid, wave, lane);
            state_store(ap->out + OFF_HS + (size_t)idx * 16384, S, wave, lane);
        }
        pool_phase(lds, ap, MISC, team, tl, tid, wave, lane);
    }
    TEAM_BAR();

    {
        PHASE_BEGIN();
        HgrnIO io{(const unsigned*)(tws + T_Q), (const unsigned*)(tws + T_V), (const unsigned*)(tws + T_SG), (const unsigned*)(tws + T_LOGF), (bf16_t*)(tws + T_A), ap->in[I_GHG]};
        f32x4 S[8]; float ldacc[2] = {0.f, 0.f};
#pragma unroll
        for (int kt = 0; kt < 8; ++kt) S[kt] = (f32x4){0.f, 0.f, 0.f, 0.f};
        if (seg > 0) {
            LAS float* DECS = (LAS float*)(lds + H_DECS);
            for (int i = tid; i < seg * 128; i += 512) DECS[i] = fexp2(((const float*)(ws + WS_LD))[seq * 8 * 128 + i]);
            __syncthreads();
            const int g4 = lane >> 4;
            const float* slb = (const float*)(ws + WS_SLOC) + (size_t)(seq * 8) * 16384;
            const f32x4* sv = (const f32x4*)slb + (wave * 8) * 64 + lane;
            int i = 0;
            for (; i + 3 < seg; i += 4) {
                f32x4 l0[8], l1[8], l2[8], l3[8];
#pragma unroll
                for (int kt = 0; kt < 8; ++kt) { l0[kt] = sv[(size_t)i * 4096 + kt * 64]; l1[kt] = sv[(size_t)(i + 1) * 4096 + kt * 64]; l2[kt] = sv[(size_t)(i + 2) * 4096 + kt * 64]; l3[kt] = sv[(size_t)(i + 3) * 4096 + kt * 64]; }
#pragma unroll
                for (int kt = 0; kt < 8; ++kt) { const LAS float* dp = DECS + i * 128 + 16 * kt + 4 * g4;
                    const f32x4 d0 = *(const LAS f32x4*)dp, d1 = *(const LAS f32x4*)(dp + 128), d2 = *(const LAS f32x4*)(dp + 256), d3 = *(const LAS f32x4*)(dp + 384);
                    S[kt] = (((S[kt] * d0 + l0[kt]) * d1 + l1[kt]) * d2 + l2[kt]) * d3 + l3[kt]; }
            }
            for (; i + 1 < seg; i += 2) {
                f32x4 l0[8], l1[8];
#pragma unroll
                for (int kt = 0; kt < 8; ++kt) { l0[kt] = sv[(size_t)i * 4096 + kt * 64]; l1[kt] = sv[(size_t)(i + 1) * 4096 + kt * 64]; }
#pragma unroll
                for (int kt = 0; kt < 8; ++kt) { const f32x4 d0 = *(const LAS f32x4*)(DECS + i * 128 + 16 * kt + 4 * g4), d1 = *(const LAS f32x4*)(DECS + (i + 1) * 128 + 16 * kt + 4 * g4);
                    S[kt] = (S[kt] * d0 + l0[kt]) * d1 + l1[kt]; }
            }
            if (i < seg) {
                f32x4 l0[8];
#pragma unroll
                for (int kt = 0; kt < 8; ++kt) l0[kt] = sv[(size_t)i * 4096 + kt * 64];
#pragma unroll
                for (int kt = 0; kt < 8; ++kt) { const f32x4 dv = *(const LAS f32x4*)(DECS + i * 128 + 16 * kt + 4 * g4); S[kt] = S[kt] * dv + l0[kt]; }
            }
        }
        hgrn_chunks<HM_FINAL, 64>(lds, io, ((seq >> 2) & 3) * SEQ + seg * 1024, 16, seq & 3, S, ldacc, tid, wave, lane);
        if (seg == 7) state_store(ap->out + OFF_HP + (size_t)seq * 16384, S, wave, lane);
    }
    TEAM_BAR();

    {
        PHASE_BEGIN();
        pg8::Gemm g{(const bf16_t*)(tws + T_A), (const bf16_t*)(ws + WS_WOUT), TROWS, DM, DM}; pg8::StaticOrder<DM / 256, 4> S; S.init(128, DM, DM, G, tl, 4, nsp_of(team));
        pg8::EpiRow E{(bf16_t*)(tws + T_C), (float*)(tws + T_SS), (float*)(tws + T_SLAB), lds + pg8::EPI_STG_OFF};
        pg8::gemm_phase<pg8::EpiRow, pg8::StaticOrder<DM / 256, 4>, true, true>(lds, g, S, E);
    }
    TEAM_BAR();

    {
        PHASE_BEGIN();
        const int gw = tl * 8 + wave, NGW = G * 8;
        f32x4 g1[4], ig0[4];
#pragma unroll
        for (int j = 0; j < 4; ++j) { g1[j] = ((const f32x4*)ap->in[I_GPOST] + lane)[64 * j]; const f32x4 g0 = ((const f32x4*)ap->in[I_GPRE] + lane)[64 * j]; ig0[j] = (f32x4){1.0f / g0.x, 1.0f / g0.y, 1.0f / g0.z, 1.0f / g0.w}; }
        const bf16_t* YM = (const bf16_t*)(tws + T_C); const bf16_t* XN = (const bf16_t*)(tws + T_XB); bf16_t* X1 = (bf16_t*)(tws + T_X1); const float* SS = (const float*)(tws + T_SS);
        const float* RS0 = (const float*)(tws + T_RS0); float* RS2 = (float*)(tws + T_RS2);
        if (gw < 256 * nsp_of(team)) {
            const int r = MP / 2 + gw; const float* sl = (const float*)(tws + T_SLAB) + ((size_t)(gw >> 8) * 4 * 256 + (gw & 255)) * DM;
            const u32x2* xr = (const u32x2*)(XN + (size_t)r * DM) + lane; const float ir0 = 1.0f / RS0[r];
            f32x4 ym[4], v[4]; float q1 = 0.f;
#pragma unroll
            for (int j = 0; j < 4; ++j) { ym[j] = ((const f32x4*)sl + lane)[64 * j];
#pragma unroll
                for (int ks = 1; ks < 4; ++ks) ym[j] += ((const f32x4*)(sl + (size_t)ks * 256 * DM) + lane)[64 * j];
                const u32x2 xx = xr[64 * j]; v[j] = (f32x4){bf_lo(xx.x), bf_hi(xx.x), bf_lo(xx.y), bf_hi(xx.y)} * ig0[j] * ir0;
                q1 += (ym[j].x * ym[j].x + ym[j].y * ym[j].y) + (ym[j].z * ym[j].z + ym[j].w * ym[j].w); }
            const float rs1 = 1.0f / sqrtf(wave_sum(q1) * (1.0f / DM) + EPS); float q = 0.f;
#pragma unroll
            for (int j = 0; j < 4; ++j) { v[j] += ym[j] * rs1 * g1[j]; q += (v[j].x * v[j].x + v[j].y * v[j].y) + (v[j].z * v[j].z + v[j].w * v[j].w); }
            const float rs2 = 1.0f / sqrtf(wave_sum(q) * (1.0f / DM) + EPS);
            if (lane == 0) RS2[r] = rs2;
            u32x2* xrow = (u32x2*)(X1 + (size_t)r * DM) + lane;
#pragma unroll
            for (int j = 0; j < 4; ++j) { u32x2 xw; xw.x = cvt_pk_bf16(v[j].x * rs2, v[j].y * rs2); xw.y = cvt_pk_bf16(v[j].z * rs2, v[j].w * rs2); xrow[64 * j] = xw; }
        }
        for (int r0 = gw * RW; r0 < MP / 2; r0 += NGW * RW) {
            u32x2 xv[RW][4], y[RW][4]; float ssp[RW], ir0[RW];
            { const f32x4 sv = *(const f32x4*)(SS + (size_t)(r0 >> 4) * 256 + (lane & 15) * 16 + (r0 & 15)); ssp[0] = sv[0]; ssp[1] = sv[1]; ssp[2] = sv[2]; ssp[3] = sv[3]; }
#pragma unroll
            for (int i = 0; i < RW; ++i) { const int r = r0 + i; const u32x2* xr = (const u32x2*)(XN + (size_t)r * DM) + lane; const u32x2* yr = (const u32x2*)(YM + (size_t)r * DM) + lane;
                ir0[i] = RS0[r];
#pragma unroll
                for (int j = 0; j < 4; ++j) { xv[i][j] = xr[64 * j]; y[i][j] = yr[64 * j]; } }
#pragma unroll
            for (int i = 0; i < RW; ++i) { const int r = r0 + i;
                const float rs1 = 1.0f / sqrtf(sum16(ssp[i]) * (1.0f / DM) + EPS), irs = 1.0f / ir0[i]; float q = 0.f; f32x4 v[4];
#pragma unroll
                for (int j = 0; j < 4; ++j) { const u32x2 xx = xv[i][j], yy = y[i][j];
                    v[j].x = bf_lo(xx.x) * ig0[j].x * irs + bf_lo(yy.x) * rs1 * g1[j].x; v[j].y = bf_hi(xx.x) * ig0[j].y * irs + bf_hi(yy.x) * rs1 * g1[j].y;
                    v[j].z = bf_lo(xx.y) * ig0[j].z * irs + bf_lo(yy.y) * rs1 * g1[j].z; v[j].w = bf_hi(xx.y) * ig0[j].w * irs + bf_hi(yy.y) * rs1 * g1[j].w;
                    q += (v[j].x * v[j].x + v[j].y * v[j].y) + (v[j].z * v[j].z + v[j].w * v[j].w); }
                const float rs2 = 1.0f / sqrtf(wave_sum(q) * (1.0f / DM) + EPS);
                if (lane == 0) RS2[r] = rs2;
                u32x2* xrow = (u32x2*)(X1 + (size_t)r * DM) + lane;
#pragma unroll
                for (int j = 0; j < 4; ++j) { u32x2 xw; xw.x = cvt_pk_bf16(v[j].x * rs2, v[j].y * rs2); xw.y = cvt_pk_bf16(v[j].z * rs2, v[j].w * rs2); xrow[64 * j] = xw; } }
        }
    }
    TEAM_BAR();

    {
        PHASE_BEGIN();
        if (team == 1) {
            if (tid == 0) { const unsigned* wf = (const unsigned*)(ws + WS_CTL) + CW_WFLAG; unsigned sp = 0;
                while (!__hip_atomic_load(wf, __ATOMIC_RELAXED, __HIP_MEMORY_SCOPE_AGENT) && ++sp < (1u << 22)) __builtin_amdgcn_s_sleep(8);
                __builtin_amdgcn_fence(__ATOMIC_ACQUIRE, "agent"); }
            __syncthreads();
        }
        pg8::Gemm g{(const bf16_t*)(tws + T_X1), (const bf16_t*)(ws + WS_WGU), TROWS, NGU, DM}; pg8::StaticOrder<NGU / 256, 0> S; S.init(128 + nsp_of(team), NGU, DM, G, tl, 0);
        pg8::EpiAct E{(bf16_t*)(tws + T_ACT)};
        pg8::gemm_phase<pg8::EpiAct, pg8::StaticOrder<NGU / 256, 0>, true, true>(lds, g, S, E);
    }
    TEAM_BAR();

    {
        PHASE_BEGIN();
        pg8::Gemm g{(const bf16_t*)(tws + T_ACT), (const bf16_t*)(ws + WS_WD), TROWS, DM, DFF}; pg8::StaticOrder<DM / 256, 11> S; S.init(128, DM, DFF, G, tl, 11, nsp_of(team));
        pg8::EpiRow E{(bf16_t*)(tws + T_C), (float*)(tws + T_SS), (float*)(tws + T_SLAB5), lds + pg8::EPI_STG_OFF};
        pg8::gemm_phase<pg8::EpiRow, pg8::StaticOrder<DM / 256, 11>, true, true, true>(lds, g, S, E);
    }
    TEAM_BAR();

    {
        PHASE_BEGIN();
        const int gw = tl * 8 + wave, NGW = G * 8;
        f32x4 g3[4];
#pragma unroll
        for (int j = 0; j < 4; ++j) g3[j] = ((const f32x4*)ap->in[I_GPOSTF] + lane)[64 * j];
        const bf16_t* FB = (const bf16_t*)(tws + T_C); const bf16_t* X1 = (const bf16_t*)(tws + T_X1); const float* SS = (const float*)(tws + T_SS); const float* RS2 = (const float*)(tws + T_RS2); float* outp = ap->out;
        if (gw < 256 * nsp_of(team)) {
            const int r = MP / 2 + gw; const float* sl = (const float*)(tws + T_SLAB5) + ((size_t)(gw >> 8) * 11 * 256 + (gw & 255)) * DM;
            const u32x2* xr = (const u32x2*)(X1 + (size_t)r * DM) + lane;
            f32x4 fm[4]; float q1 = 0.f;
#pragma unroll
            for (int j = 0; j < 4; ++j) { fm[j] = ((const f32x4*)sl + lane)[64 * j];
#pragma unroll
                for (int ks = 1; ks < 11; ++ks) fm[j] += ((const f32x4*)(sl + (size_t)ks * 256 * DM) + lane)[64 * j];
                q1 += (fm[j].x * fm[j].x + fm[j].y * fm[j].y) + (fm[j].z * fm[j].z + fm[j].w * fm[j].w); }
            const float rs3 = 1.0f / sqrtf(wave_sum(q1) * (1.0f / DM) + EPS), ir2 = 1.0f / RS2[r];
            f32x4* orow = (f32x4*)(outp + OFF_Y + (size_t)team_row(team, r) * DM) + lane;
#pragma unroll
            for (int j = 0; j < 4; ++j) { const u32x2 xx = xr[64 * j]; f32x4 x;
                x.x = bf_lo(xx.x) * ir2 + fm[j].x * rs3 * g3[j].x; x.y = bf_hi(xx.x) * ir2 + fm[j].y * rs3 * g3[j].y; x.z = bf_lo(xx.y) * ir2 + fm[j].z * rs3 * g3[j].z; x.w = bf_hi(xx.y) * ir2 + fm[j].w * rs3 * g3[j].w;
                orow[64 * j] = x; }
        }
        unsigned* ctlw = (unsigned*)(ws + WS_CTL);
        if (tl == 0 && tid == 0) __hip_atomic_store(ctlw + CW_FLAG + 64 * team, 1u, __ATOMIC_RELAXED, __HIP_MEMORY_SCOPE_AGENT);
        ROWQ_BEGIN(ctlw + CW_ROWQ + 64 * team)
            p5b_rows(tws, team, r0, outp, g3, lane);
        ROWQ_END()
        {
            const int ot = team ^ 1;
            if (tid == 0) { unsigned sp = 0, ok = 0;
                for (;;) { ok = __hip_atomic_load(ctlw + CW_FLAG + 64 * ot, __ATOMIC_RELAXED, __HIP_MEMORY_SCOPE_AGENT); if (ok || ++sp > (1u << 16)) break; __builtin_amdgcn_s_sleep(8); }
                __builtin_amdgcn_fence(__ATOMIC_ACQUIRE, "agent"); asm volatile("s_waitcnt vmcnt(0)" ::: "memory");
                MISC[9] = ok; }
            __syncthreads();
            if (MISC[9]) {
                unsigned char* otw = ws + WS_TEAM + (size_t)ot * TEAM_BYTES;
                ROWQ_BEGIN(ctlw + CW_ROWQ + 64 * ot)
                    p5b_rows(otw, ot, r0, outp, g3, lane);
                ROWQ_END()
            }
        }
    }
}

extern "C" void kernel_launch(void* const* d_in, const int* in_sizes, int n_in, void* d_out, int out_size, void* d_ws, size_t ws_size, hipStream_t stream) {
    static int grid = 0;
    if (grid == 0) {
        if (n_in != 17 || in_sizes[0] != MP * DM || ws_size < WS_END) { fprintf(stderr, "kernel_launch: unexpected shapes (n_in %d, in0 %d, ws %zu); nothing launched\n", n_in, n_in > 0 ? in_sizes[0] : -1, ws_size); grid = -1; return; }
        int dev = 0, cus = 0, per_cu = 0;
        hipGetDevice(&dev);
        hipDeviceGetAttribute(&cus, hipDeviceAttributeMultiprocessorCount, dev);
        if (hipFuncSetAttribute((const void*)fwd_megakernel, hipFuncAttributeMaxDynamicSharedMemorySize, LDS_BYTES) != hipSuccess) { fprintf(stderr, "kernel_launch: hipFuncSetAttribute failed\n"); grid = -1; return; }
        hipOccupancyMaxActiveBlocksPerMultiprocessor(&per_cu, (const void*)fwd_megakernel, 512, LDS_BYTES);
        if (per_cu < 1) { fprintf(stderr, "kernel_launch: occupancy query says %d blocks per CU\n", per_cu); per_cu = 1; }
        (void)hipGetLastError();
        grid = cus;
        if (grid != 256) fprintf(stderr, "kernel_launch: %d CUs; this kernel is laid out for 256\n", grid);
        if (grid > 256) grid = 256;
    }
    if (grid < 0) return;
    if (hipMemsetAsync((char*)d_ws + WS_CTL, 0, CTL_ZERO_BYTES, stream) != hipSuccess) { fprintf(stderr, "kernel_launch: memset failed\n"); return; }
    Args a{};
    for (int i = 0; i < 17; ++i) a.in[i] = (const float*)d_in[i];
    a.out = (float*)d_out; a.ws = (unsigned char*)d_ws;
    void* args[] = {&a};
    hipError_t e = hipLaunchCooperativeKernel((const void*)fwd_megakernel, dim3(grid), dim3(512), args, LDS_BYTES, stream);
    if (e != hipSuccess) fprintf(stderr, "cooperative launch failed: %s (grid %d)\n", hipGetErrorString(e), grid);
}
```
